# Optimizing an MI355X kernel written in HIP

```python
import math
import jax, jax.numpy as jnp
from jax import lax
import numpy as np

D_MODEL = 4096
BATCH = 4
SEQ = 2048
DEPTH = 1
DEC_BATCH = 128
DEC_SEQ = 8
PAST_LEN = 8192
PAGE_SIZE = 128

M_HEADS = 8
M_WIDTH = D_MODEL // 2
M_HEAD_DIM = M_WIDTH // M_HEADS
M_CHUNK = 64
A_HEAD_DIM = 64
A_WIDTH = D_MODEL // 2
A_HEADS = A_WIDTH // A_HEAD_DIM
A_KV_HEADS = A_HEADS // 4
A_GROUP = A_HEADS // A_KV_HEADS
A_KV_WIDTH = A_KV_HEADS * A_HEAD_DIM
WINDOW = 128
ROPE_THETA = 10000.0
LN_EPS = 1e-5
DEEPNORM_ALPHA = (2.0 * DEPTH) ** 0.25
DEEPNORM_BETA = (8.0 * DEPTH) ** -0.25

IN_COLUMNS = (('q_m', M_WIDTH), ('k_m', M_WIDTH), ('v_m', M_WIDTH), ('o_m', M_WIDTH), ('z_m', M_WIDTH),
              ('i_m', M_HEADS), ('f_m', M_HEADS),
              ('q_a', A_WIDTH), ('k_a', A_KV_WIDTH), ('v_a', A_KV_WIDTH), ('z_a', A_WIDTH),
              ('g_m', D_MODEL), ('g_a', D_MODEL))
IN_WIDTH = sum(size for _, size in IN_COLUMNS)
SPLIT_POINTS = tuple(int(p) for p in np.cumsum([size for _, size in IN_COLUMNS])[:-1])

kernel_name = 'hybrid_mlstm_swa_sink_decode_step'


def _layer_norm(x, g, b):
    xf = x.astype(jnp.float32)
    mu = xf.mean(-1, keepdims=True)
    var = jnp.mean(jnp.square(xf - mu), -1, keepdims=True)
    return ((xf - mu) * lax.rsqrt(var + LN_EPS) * g + b).astype(x.dtype)


def _rope(x, pos):
    half = x.shape[-1] // 2
    inv = ROPE_THETA ** (-jnp.arange(half, dtype=jnp.float32) / half)
    ang = pos.astype(jnp.float32)[:, None] * inv[None, :]
    cos = jnp.cos(ang)[None, :, None, :]
    sin = jnp.sin(ang)[None, :, None, :]
    xf = x.astype(jnp.float32)
    x1, x2 = xf[..., :half], xf[..., half:]
    return jnp.concatenate([x1 * cos - x2 * sin, x2 * cos + x1 * sin], -1).astype(x.dtype)


def _mlstm_scan(q, k, v, ig, lf, C0, n0, m0):
    B, H, T, _ = q.shape
    L = math.gcd(T, M_CHUNK)
    nc = T // L
    causal = jnp.tril(jnp.ones((L, L), bool))

    def to_chunks(a):
        return jnp.moveaxis(a.reshape((B, H, nc, L) + a.shape[3:]), 2, 0)

    def step(carry, xs):
        C, n, m = carry
        qc, kc, vc, ic, fc = xs
        b = jnp.cumsum(fc, axis=-1)
        log_d = b[..., :, None] - b[..., None, :] + ic[..., None, :]
        log_d = jnp.where(causal, log_d, -jnp.inf)
        a = b + m[..., None]
        m_t = jnp.maximum(a, log_d.max(-1))
        s = jnp.einsum('bhtd,bhsd->bhts', qc, kc) * jnp.exp(log_d - m_t[..., None])
        inter = jnp.exp(a - m_t)
        num = jnp.einsum('bhts,bhse->bhte', s, vc) + inter[..., None] * jnp.einsum('bhtd,bhde->bhte', qc, C)
        den = s.sum(-1) + inter * jnp.einsum('bhtd,bhd->bht', qc, n)
        h = num / jnp.maximum(jnp.abs(den), jnp.exp(-m_t))[..., None]
        m_new = m_t[..., -1]
        w = jnp.exp(b[..., -1:] - b + ic - m_new[..., None])
        decay = jnp.exp(b[..., -1] + m - m_new)
        C_new = decay[..., None, None] * C + jnp.einsum('bhsd,bhse->bhde', w[..., None] * kc, vc)
        n_new = decay[..., None] * n + jnp.einsum('bhs,bhsd->bhd', w, kc)
        return (C_new, n_new, m_new), h

    init = (C0.astype(jnp.float32), n0.astype(jnp.float32), m0.astype(jnp.float32))
    (C, n, m), h = lax.scan(step, init, tuple(to_chunks(a) for a in (q, k, v, ig, lf)))
    h = jnp.moveaxis(h, 0, 2).reshape(B, H, T, v.shape[-1])
    return h, C, n, m


def _mlstm_branch(qm, km, vm, om, zm, im, fm, b_if, norm_m_g, state0):
    B, T, _ = qm.shape

    def heads(a):
        return a.reshape(B, T, M_HEADS, -1).transpose(0, 2, 1, 3).astype(jnp.float32)

    q = heads(qm)
    k = heads(km) * (M_HEAD_DIM ** -0.5)
    v = heads(vm)
    ig = (im.astype(jnp.float32) + b_if[:M_HEADS]).transpose(0, 2, 1)
    lf = jax.nn.log_sigmoid(fm.astype(jnp.float32) + b_if[M_HEADS:]).transpose(0, 2, 1)
    h, C, n, m = _mlstm_scan(q, k, v, ig, lf, *state0)
    h = jax.nn.sigmoid(om.astype(jnp.float32)).reshape(B, T, M_HEADS, M_HEAD_DIM) * h.transpose(0, 2, 1, 3)
    mu = h.mean(-1, keepdims=True)
    var = jnp.mean(jnp.square(h - mu), -1, keepdims=True)
    h = (h - mu) * lax.rsqrt(var + LN_EPS) * norm_m_g.reshape(M_HEADS, M_HEAD_DIM)
    out = h.reshape(B, T, M_WIDTH).astype(qm.dtype) * jax.nn.silu(zm)
    return out, C, n, m


def _sink_probs(s, mask, sink):
    s = jnp.where(mask, s, -jnp.inf)
    mx = jnp.maximum(s.max(-1, keepdims=True), sink)
    p = jnp.exp(s - mx)
    return p / (p.sum(-1, keepdims=True) + jnp.exp(sink - mx))


def _swa_prompt(q, k, v, sinks):
    B, S, H, hd = q.shape
    nb = S // WINDOW
    qb = q.reshape(B, nb, WINDOW, A_KV_HEADS, A_GROUP, hd)
    kb = k.reshape(B, nb, WINDOW, A_KV_HEADS, hd)
    vb = v.reshape(B, nb, WINDOW, A_KV_HEADS, hd)

    def with_prev(a):
        prev = jnp.pad(a[:, :-1], ((0, 0), (1, 0), (0, 0), (0, 0), (0, 0)))
        return jnp.concatenate([prev, a], axis=2)

    kk, vv = with_prev(kb), with_prev(vb)
    s = jnp.einsum('bnqkgd,bnskd->bnkgqs', qb, kk).astype(jnp.float32) * (hd ** -0.5)
    blk = jnp.arange(nb)[:, None, None] * WINDOW
    qpos = blk + jnp.arange(WINDOW)[None, :, None]
    kpos = blk - WINDOW + jnp.arange(2 * WINDOW)[None, None, :]
    rel = qpos - kpos
    mask = (rel >= 0) & (rel < WINDOW) & (kpos >= 0)
    sink = sinks.reshape(A_KV_HEADS, A_GROUP)[:, :, None, None].astype(jnp.float32)
    p = _sink_probs(s, mask[None, :, None, None], sink)
    o = jnp.einsum('bnkgqs,bnskd->bnqkgd', p.astype(vv.dtype), vv)
    return o.reshape(B, S, H * hd)


def _swa_sample(q, k, v, cache_k, cache_v, sinks):
    B, T, H, hd = q.shape
    w_buf = cache_k.shape[1]
    kk = jnp.concatenate([cache_k.astype(k.dtype), k], axis=1)
    vv = jnp.concatenate([cache_v.astype(v.dtype), v], axis=1)
    qg = q.reshape(B, T, A_KV_HEADS, A_GROUP, hd)
    s = jnp.einsum('btkgd,bskd->bkgts', qg, kk).astype(jnp.float32) * (hd ** -0.5)
    qpos = PAST_LEN + jnp.arange(T)
    kpos = PAST_LEN - w_buf + jnp.arange(w_buf + T)
    rel = qpos[:, None] - kpos[None, :]
    mask = (rel >= 0) & (rel < WINDOW)
    sink = sinks.reshape(A_KV_HEADS, A_GROUP)[:, :, None, None].astype(jnp.float32)
    p = _sink_probs(s, mask, sink)
    o = jnp.einsum('bkgts,bskd->btkgd', p.astype(vv.dtype), vv).reshape(B, T, H * hd)
    return o, kk[:, -w_buf:], vv[:, -w_buf:]


def _hybrid_layer(x, positions, state0, attend, w_in, b_if, norm_m_g, w_bm, w_ba, w_out, ln_g, ln_b):
    B, T, _ = x.shape
    qm, km, vm, om, zm, im, fm, qa, ka, va, za, gm, ga = jnp.split(x @ w_in, SPLIT_POINTS, axis=-1)
    mix_m, C, n, m = _mlstm_branch(qm, km, vm, om, zm, im, fm, b_if, norm_m_g, state0)
    qa = _rope(qa.reshape(B, T, A_HEADS, A_HEAD_DIM), positions)
    ka = _rope(ka.reshape(B, T, A_KV_HEADS, A_HEAD_DIM), positions)
    va = va.reshape(B, T, A_KV_HEADS, A_HEAD_DIM)
    att, k_buf, v_buf = attend(qa, ka, va)
    mix_a = att * jax.nn.silu(za)
    merged = jax.nn.sigmoid(gm) * (mix_m @ w_bm) + jax.nn.sigmoid(ga) * (mix_a @ w_ba)
    y = _layer_norm(DEEPNORM_ALPHA * x + merged @ w_out, ln_g, ln_b)
    return y, C, n, m, k_buf, v_buf


def setup_inputs(seed: int = 0) -> dict:
    key = jax.random.key(seed)
    ks = jax.random.split(key, 18)
    f32 = jnp.float32
    w_buf = min(WINDOW, PAST_LEN)

    def nrm(k, shape):
        return jax.random.normal(k, shape, f32)

    col_scale = jnp.concatenate([jnp.full((size,), DEEPNORM_BETA if name in ('v_m', 'v_a') else 1.0, f32)
                                 for name, size in IN_COLUMNS])
    return {
        'x_prompt': nrm(ks[0], (BATCH, SEQ, D_MODEL)),
        'x_sample': nrm(ks[1], (DEC_BATCH, DEC_SEQ, D_MODEL)),
        'state_C': 0.3 * nrm(ks[2], (DEPTH, DEC_BATCH, M_HEADS, M_HEAD_DIM, M_HEAD_DIM)),
        'state_n': 0.1 * nrm(ks[3], (DEPTH, DEC_BATCH, M_HEADS, M_HEAD_DIM)),
        'state_m': 0.5 * nrm(ks[4], (DEPTH, DEC_BATCH, M_HEADS)),
        'cache_k': nrm(ks[5], (DEPTH, DEC_BATCH, w_buf, A_KV_HEADS, A_HEAD_DIM)),
        'cache_v': nrm(ks[6], (DEPTH, DEC_BATCH, w_buf, A_KV_HEADS, A_HEAD_DIM)),
        'w_in': nrm(ks[7], (DEPTH, D_MODEL, IN_WIDTH)) * (D_MODEL ** -0.5) * col_scale,
        'b_if': jnp.concatenate([0.1 * nrm(ks[8], (DEPTH, M_HEADS)),
                                 3.0 + 3.0 * jax.random.uniform(ks[9], (DEPTH, M_HEADS), f32)], axis=-1),
        'norm_m_g': 1.0 + 0.02 * nrm(ks[10], (DEPTH, M_WIDTH)),
        'attn_sinks': 0.5 * nrm(ks[11], (DEPTH, A_HEADS)),
        'w_bm': nrm(ks[12], (DEPTH, M_WIDTH, D_MODEL)) * (M_WIDTH ** -0.5 * DEEPNORM_BETA),
        'w_ba': nrm(ks[13], (DEPTH, A_WIDTH, D_MODEL)) * (A_WIDTH ** -0.5 * DEEPNORM_BETA),
        'w_out': nrm(ks[14], (DEPTH, D_MODEL, D_MODEL)) * (D_MODEL ** -0.5 * DEEPNORM_BETA),
        'ln_g': 1.0 + 0.02 * nrm(ks[15], (DEPTH, D_MODEL)),
        'ln_b': 0.02 * nrm(ks[16], (DEPTH, D_MODEL)),
    }


def reference(x_prompt, x_sample, state_C, state_n, state_m, cache_k, cache_v, w_in, b_if, norm_m_g,
              attn_sinks, w_bm, w_ba, w_out, ln_g, ln_b):
    bp, seq = x_prompt.shape[0], x_prompt.shape[1]
    w_buf = cache_k.shape[2]
    pos_prompt = jnp.arange(seq)
    pos_sample = PAST_LEN + jnp.arange(x_sample.shape[1])
    fresh_state = (jnp.zeros((bp, M_HEADS, M_HEAD_DIM, M_HEAD_DIM), jnp.float32),
                   jnp.zeros((bp, M_HEADS, M_HEAD_DIM), jnp.float32),
                   jnp.zeros((bp, M_HEADS), jnp.float32))
    y_p, y_s = x_prompt, x_sample
    outs_p, outs_s = [], []
    for l in range(DEPTH):
        weights = (w_in[l], b_if[l], norm_m_g[l], w_bm[l], w_ba[l], w_out[l], ln_g[l], ln_b[l])
        sinks = attn_sinks[l]
        ck, cv = cache_k[l], cache_v[l]

        def attend_prompt(q, k, v):
            return _swa_prompt(q, k, v, sinks), k[:, seq - w_buf:], v[:, seq - w_buf:]

        def attend_sample(q, k, v):
            return _swa_sample(q, k, v, ck, cv, sinks)

        y_p, *st_p = _hybrid_layer(y_p, pos_prompt, fresh_state, attend_prompt, *weights)
        y_s, *st_s = _hybrid_layer(y_s, pos_sample, (state_C[l], state_n[l], state_m[l]), attend_sample, *weights)
        outs_p.append(st_p)
        outs_s.append(st_s)

    def stack(outs, i, like):
        return jnp.stack([o[i] for o in outs]).astype(like.dtype)

    return (y_p, y_s,
            stack(outs_p, 0, state_C), stack(outs_p, 1, state_n), stack(outs_p, 2, state_m),
            stack(outs_p, 3, cache_k), stack(outs_p, 4, cache_v),
            stack(outs_s, 0, state_C), stack(outs_s, 1, state_n), stack(outs_s, 2, state_m),
            stack(outs_s, 3, cache_k), stack(outs_s, 4, cache_v))
```

```cpp
#include <hip/hip_runtime.h>
#include <hip/hip_cooperative_groups.h>
#include <cstdio>
#include <cstdint>
namespace cg = cooperative_groups;
static __device__ __forceinline__ int TID() { int t = threadIdx.x; asm volatile("" : "+v"(t)); return t; }
static __device__ __forceinline__ int BID() { int t = blockIdx.x; asm volatile("" : "+s"(t)); return t; }
namespace pg8 {
#define PG8_LAS __attribute__((address_space(3)))
typedef unsigned short bf16_t;
typedef short bf16x8 __attribute__((ext_vector_type(8)));
typedef float f32x4 __attribute__((ext_vector_type(4)));
typedef unsigned u32x4 __attribute__((ext_vector_type(4)));
constexpr int BM = 256, BK = 64, HALF = 128, HTB = HALF * BK * 2  , STAGE_BYTES = 8 * HTB, NXCD = 8, WGM = 8;

__host__ __device__ __forceinline__ int lds_byte(int r, int c) { const int st = (r >> 4) * 2 + (c >> 5), rr = r & 15, cc = c & 31, ob = rr * 64 + cc * 2; return st * 1024 + (ob ^ (((ob >> 9) & 1) << 5)); }
__host__ __device__ __forceinline__ void stage_rc(int b, int& R, int& C) { const int st = b / 1024, sb = b % 1024, swz = sb ^ (((sb >> 9) & 1) << 5); R = (st >> 1) * 16 + swz / 64; C = (st & 1) * 32 + (swz % 64) / 2; }
__host__ __device__ __forceinline__ int perm32(int rho) { const int n = rho >> 4, i = rho & 15; return 8 * (i >> 2) + 4 * n + (i & 3); }

struct Unit { int pm, pn; };
struct Gemm { const bf16_t* A; const bf16_t* Bt; int M, N, K, lda, ldb; };

struct StaticOrder {
    int nM, nN, nwg, G, c;
    __host__ __device__ void init(int M, int N, int G_, int c_) { nM = M / BM; nN = N / BM; nwg = nM * nN; G = G_; c = c_; }
    __host__ __device__ bool next(int i, Unit& u) const {
        const long L = (long)i * G + c; if (L >= nwg) return false;
        int wgid = (int)L; { const int q = nwg / NXCD, r = nwg % NXCD, xcd = wgid % NXCD, off = wgid / NXCD; wgid = (xcd < r ? xcd * (q + 1) : r * (q + 1) + (xcd - r) * q) + off; }
        const int nig = WGM * nN, gid = wgid / nig, fm = gid * WGM, gsz = (nM - fm) < WGM ? (nM - fm) : WGM;
        u.pm = fm + ((wgid % nig) % gsz); u.pn = (wgid % nig) / gsz; return true;
    }
    __device__ __forceinline__ void a_ready(const Unit&) const {}
    __device__ __forceinline__ void done(const Unit&) const {}
};
__device__ __forceinline__ unsigned cvt_pk_bf16(float lo, float hi) { unsigned r; asm volatile("v_cvt_pk_bf16_f32 %0, %1, %2" : "=v"(r) : "v"(lo), "v"(hi)); return r; }
typedef float f32x2 __attribute__((ext_vector_type(2)));
template <int ACT> struct EpiBf16 {
    static constexpr bool PERM = true, AFTER_DRAIN = false;
    bf16_t* O; int ldc; const float* bias; int split_cols; size_t split_stride;
    __device__ __forceinline__ void operator()(const f32x4 (&acc)[2][2][4][2], const Unit& u, int wr, int wc, int fr, int fq) const {
        const int row0 = u.pm * BM + wr * 64 + fr, col0 = u.pn * BM + wc * 32 + 8 * fq;
#pragma unroll
        for (int ai = 0; ai < 2; ++ai)
#pragma unroll
            for (int m = 0; m < 4; ++m) { bf16_t* rowp = O + (size_t)(row0 + ai * HALF + m * 16) * ldc + col0;
#pragma unroll
                for (int bj = 0; bj < 2; ++bj) { const f32x4 v0 = acc[ai][bj][m][0], v1 = acc[ai][bj][m][1];
                    u32x4 w; w.x = cvt_pk_bf16(v0[0], v0[1]); w.y = cvt_pk_bf16(v0[2], v0[3]); w.z = cvt_pk_bf16(v1[0], v1[1]); w.w = cvt_pk_bf16(v1[2], v1[3]);
                    *(u32x4*)(rowp + bj * HALF) = w; } }
    }
};
template <class Epi, class Sched, bool ALIGN_EPI = false, bool SP2 = false>
__device__ __forceinline__ void gemm_phase(PG8_LAS unsigned char* lds, const Gemm g, const Sched& S, const Epi& E) {
    const int tid = TID(), wid = __builtin_amdgcn_readfirstlane(tid >> 6), lane = tid & 63, wr = wid >> 2, wc = wid & 3, fr = lane & 15, fq = lane >> 4;
    const int K = g.K, nt = K / BK;
    unsigned voffA[2], voffB[2];
#pragma unroll
    for (int i = 0; i < 2; ++i) { int R, C; stage_rc(tid * 16 + i * 8192, R, C); const int Rb = Epi::PERM ? ((R & ~31) + perm32(R & 31)) : R;
        voffA[i] = (unsigned)(R * g.lda + C) * 2u; voffB[i] = (unsigned)(Rb * g.ldb + C) * 2u; }
    const size_t kstep = (size_t)(BK * 2);
    const size_t hstepA = (size_t)HALF * g.lda * 2, hstepB = (size_t)HALF * g.ldb * 2;
    const size_t tstepA = 2 * hstepA, tstepB = 2 * hstepB;
    const unsigned ldsw = (unsigned)wid * 1024u;
    const int aoff = lds_byte(wr * 64 + fr, fq * 8), boff = lds_byte(wc * 32 + fr, fq * 8);
#define PG8_SA(b, h) (((b) * 2 + (h)) * HTB)
#define PG8_SB(b, h) ((4 + (b) * 2 + (h)) * HTB)
#define PG8_STAGE(bufoff, gbase, voff) do { _Pragma("unroll") for (int _i = 0; _i < 2; ++_i) \
        __builtin_amdgcn_global_load_lds((const unsigned*)((const char*)(gbase) + (voff)[_i]), (PG8_LAS unsigned*)(lds + (bufoff) + ldsw + _i * 8192), 16, 0, 0); } while (0)
#define PG8_LDA(dst, b, h) do { _Pragma("unroll") for (int m = 0; m < 4; ++m) _Pragma("unroll") for (int k = 0; k < 2; ++k) dst[m][k] = *(const PG8_LAS bf16x8*)(lds + PG8_SA(b, h) + aoff + m * 2048 + k * 1024); } while (0)
#define PG8_LDB(dst, b, h) do { _Pragma("unroll") for (int n = 0; n < 2; ++n) _Pragma("unroll") for (int k = 0; k < 2; ++k) dst[n][k] = *(const PG8_LAS bf16x8*)(lds + PG8_SB(b, h) + boff + n * 2048 + k * 1024); } while (0)
#define PG8_MMA(ai, bj, At, Bt) do { __builtin_amdgcn_s_setprio(1); _Pragma("unroll") for (int m = 0; m < 4; ++m) _Pragma("unroll") for (int n = 0; n < 2; ++n) _Pragma("unroll") for (int k = 0; k < 2; ++k) \
        acc[ai][bj][m][n] = __builtin_amdgcn_mfma_f32_16x16x32_bf16(Bt[n][k], At[m][k], acc[ai][bj][m][n], 0, 0, 0); __builtin_amdgcn_s_setprio(0); } while (0)
#define PG8_WAIT_V(n) asm volatile("s_waitcnt vmcnt(" #n ")" ::: "memory")
#define PG8_WAIT_L(n) asm volatile("s_waitcnt lgkmcnt(" #n ")" ::: "memory")
#define PG8_BAR __builtin_amdgcn_s_barrier()
#define PG8_SCHED __builtin_amdgcn_sched_barrier(0)
    Unit cur, nxt; int ui = 0;
    if (!S.next(0, cur)) return;
    f32x4 acc[2][2][4][2];
#pragma unroll
    for (int a = 0; a < 2; ++a)
#pragma unroll
        for (int b = 0; b < 2; ++b)
#pragma unroll
            for (int m = 0; m < 4; ++m)
#pragma unroll
                for (int n = 0; n < 2; ++n) acc[a][b][m][n] = (f32x4){0.f, 0.f, 0.f, 0.f};
    bf16x8 At[4][2], B0[2][2], B1[2][2];
    const char* cA = (const char*)g.A + (size_t)cur.pm * tstepA; const char* cB = (const char*)g.Bt + (size_t)cur.pn * tstepB;
    S.a_ready(cur);
    if constexpr (SP2) {
        PG8_STAGE(PG8_SB(0, 0), cB, voffB); PG8_STAGE(PG8_SB(0, 1), cB + hstepB, voffB); PG8_STAGE(PG8_SA(0, 0), cA, voffA); PG8_STAGE(PG8_SA(0, 1), cA + hstepA, voffA);
        if (wr == 1) PG8_BAR;
        PG8_WAIT_V(2); PG8_BAR;
        PG8_STAGE(PG8_SB(1, 0), cB + kstep, voffB); PG8_STAGE(PG8_SA(1, 0), cA + kstep, voffA); PG8_STAGE(PG8_SB(1, 1), cB + hstepB + kstep, voffB);
        PG8_WAIT_V(6); PG8_BAR;
    } else {
        PG8_STAGE(PG8_SB(0, 0), cB, voffB); PG8_STAGE(PG8_SA(0, 0), cA, voffA); PG8_STAGE(PG8_SB(0, 1), cB + hstepB, voffB); PG8_STAGE(PG8_SA(0, 1), cA + hstepA, voffA);
        if (wr == 1) PG8_BAR;
        PG8_WAIT_V(4); PG8_BAR;
        PG8_STAGE(PG8_SB(1, 0), cB + kstep, voffB); PG8_STAGE(PG8_SA(1, 0), cA + kstep, voffA); PG8_STAGE(PG8_SB(1, 1), cB + hstepB + kstep, voffB);
        PG8_WAIT_V(6); PG8_BAR;
    }
    for (;;) {
        const bool has_next = S.next(ui + 1, nxt);
        const char* nA = has_next ? (const char*)g.A + (size_t)nxt.pm * tstepA : cA; const char* nB = has_next ? (const char*)g.Bt + (size_t)nxt.pn * tstepB : cB;
        for (int t = 0; t < nt; t += 2) {
            const bool last = (t == nt - 2);
            const char* a1 = cA + (size_t)(t + 1) * kstep;
            const char* a2 = last ? nA : cA + (size_t)(t + 2) * kstep; const char* b2 = last ? nB : cB + (size_t)(t + 2) * kstep;
            const char* a3 = a2 + kstep; const char* b3 = b2 + kstep;
            if (last && has_next) S.a_ready(nxt);
            if constexpr (SP2) {
            PG8_LDB(B0, 0, 0); PG8_LDB(B1, 0, 1); PG8_SCHED; PG8_LDA(At, 0, 0); PG8_STAGE(PG8_SA(1, 1), a1 + hstepA, voffA);
            PG8_WAIT_V(8); PG8_WAIT_L(0); PG8_BAR; PG8_MMA(0, 0, At, B0); PG8_MMA(0, 1, At, B1); PG8_BAR; PG8_SCHED;
            PG8_LDA(At, 0, 1); PG8_STAGE(PG8_SB(0, 0), b2, voffB); PG8_STAGE(PG8_SB(0, 1), b2 + hstepB, voffB); PG8_STAGE(PG8_SA(0, 0), a2, voffA);
            PG8_WAIT_V(8); PG8_WAIT_L(0); PG8_BAR; PG8_MMA(1, 0, At, B0); PG8_MMA(1, 1, At, B1); PG8_BAR; PG8_SCHED;
            PG8_LDB(B0, 1, 0); PG8_LDB(B1, 1, 1); PG8_SCHED; PG8_LDA(At, 1, 0); PG8_STAGE(PG8_SA(0, 1), a2 + hstepA, voffA);
            PG8_WAIT_V(8); PG8_WAIT_L(0); PG8_BAR; PG8_MMA(0, 0, At, B0); PG8_MMA(0, 1, At, B1); PG8_BAR; PG8_SCHED;
            PG8_LDA(At, 1, 1); PG8_STAGE(PG8_SB(1, 0), b3, voffB); PG8_STAGE(PG8_SB(1, 1), b3 + hstepB, voffB); PG8_STAGE(PG8_SA(1, 0), a3, voffA);
            PG8_WAIT_V(8); PG8_WAIT_L(0); PG8_BAR; PG8_MMA(1, 0, At, B0); PG8_MMA(1, 1, At, B1); PG8_BAR; PG8_SCHED;
            } else {
            PG8_LDB(B0, 0, 0); PG8_SCHED; PG8_LDA(At, 0, 0); PG8_STAGE(PG8_SA(1, 1), a1 + hstepA, voffA);
            PG8_WAIT_L(8); PG8_BAR; PG8_WAIT_L(0); PG8_MMA(0, 0, At, B0); PG8_BAR; PG8_SCHED;
            PG8_LDB(B1, 0, 1); PG8_STAGE(PG8_SB(0, 0), b2, voffB);
            PG8_BAR; PG8_WAIT_L(0); PG8_MMA(0, 1, At, B1); PG8_BAR;
            PG8_LDA(At, 0, 1); PG8_STAGE(PG8_SA(0, 0), a2, voffA);
            PG8_BAR; PG8_WAIT_L(0); PG8_MMA(1, 0, At, B0); PG8_BAR; PG8_SCHED;
            PG8_STAGE(PG8_SB(0, 1), b2 + hstepB, voffB);
            PG8_WAIT_V(6); PG8_BAR; PG8_MMA(1, 1, At, B1); PG8_BAR;
            PG8_LDB(B0, 1, 0); PG8_SCHED; PG8_LDA(At, 1, 0); PG8_STAGE(PG8_SA(0, 1), a2 + hstepA, voffA);
            PG8_WAIT_L(8); PG8_BAR; PG8_WAIT_L(0); PG8_MMA(0, 0, At, B0); PG8_BAR; PG8_SCHED;
            PG8_LDB(B1, 1, 1); PG8_STAGE(PG8_SB(1, 0), b3, voffB);
            PG8_BAR; PG8_WAIT_L(0); PG8_MMA(0, 1, At, B1); PG8_BAR;
            PG8_LDA(At, 1, 1); PG8_STAGE(PG8_SA(1, 0), a3, voffA);
            PG8_BAR; PG8_WAIT_L(0); PG8_MMA(1, 0, At, B0); PG8_BAR; PG8_SCHED;
            PG8_STAGE(PG8_SB(1, 1), b3 + hstepB, voffB);
            PG8_WAIT_V(6); PG8_BAR; PG8_MMA(1, 1, At, B1); PG8_BAR;
            }
        }
        if constexpr (ALIGN_EPI) { if (wr == 0) PG8_BAR; }
        if constexpr (!Epi::AFTER_DRAIN) { E(acc, cur, wr, wc, fr, fq); S.done(cur); }
        if (!has_next) break;
#pragma unroll
        for (int a = 0; a < 2; ++a)
#pragma unroll
            for (int b = 0; b < 2; ++b)
#pragma unroll
                for (int m = 0; m < 4; ++m)
#pragma unroll
                    for (int n = 0; n < 2; ++n) acc[a][b][m][n] = (f32x4){0.f, 0.f, 0.f, 0.f};
        cur = nxt; cA = nA; cB = nB; ++ui;
        if constexpr (ALIGN_EPI) { if (wr == 1) PG8_BAR; }
    }
    PG8_WAIT_V(0);
    if constexpr (!ALIGN_EPI) { if (wr == 0) PG8_BAR; }
    PG8_BAR;
    if constexpr (Epi::AFTER_DRAIN) { E.fused(acc, cur, wr, wc, fr, fq, lds, wid, lane); S.done(cur); }
#undef PG8_SA
#undef PG8_SB
#undef PG8_STAGE
#undef PG8_LDA
#undef PG8_LDB
#undef PG8_MMA
#undef PG8_WAIT_V
#undef PG8_WAIT_L
#undef PG8_BAR
#undef PG8_SCHED
}
}
#define LAS __attribute__((address_space(3)))
#define DI __device__ __forceinline__
typedef unsigned short bf16;
typedef short bf16x8 __attribute__((ext_vector_type(8)));
typedef float f32x4 __attribute__((ext_vector_type(4)));
typedef float f32x2 __attribute__((ext_vector_type(2)));
typedef unsigned u32x4 __attribute__((ext_vector_type(4)));
typedef unsigned u32x2 __attribute__((ext_vector_type(2)));

constexpr int DM = 4096, NTOK = 9216, NPR = 8192, SEQ = 2048;
constexpr int LDY = 23552;
constexpr int C_QM = 0, C_KM = 2048, C_VM = 4096, C_OM = 6144, C_ZM = 8192, C_QA = 10240, C_KA = 12288, C_VA = 12800, C_ZA = 13312, C_GM = 15360, C_GA = 19456;
constexpr int LDW = 23568;
constexpr int NROPE = 2056;
constexpr size_t O_YP = 0, O_YS = 33554432, O_PC = 37748736, O_PN = 39845888, O_PM = 39854080, O_PK = 39854112, O_PV = 40116256,
                 O_SC = 40378400, O_SN = 107487264, O_SM = 107749408, O_SK = 107750432, O_SV = 116139040;
constexpr size_t WS_XB = 0;
constexpr size_t WS_WINT = WS_XB + (size_t)NTOK * DM * 2;
constexpr size_t WS_WBT = WS_WINT + (size_t)LDY * DM * 2;
constexpr size_t WS_WOT = WS_WBT + (size_t)DM * DM * 2;
constexpr size_t WS_Y1 = WS_WOT + (size_t)DM * DM * 2;
constexpr size_t WS_G4 = WS_Y1 + (size_t)NTOK * LDY * 2;
constexpr size_t WS_ROPE = WS_G4 + (size_t)4 * NTOK * 16 * 4;
constexpr size_t WS_HB = WS_ROPE + (size_t)NROPE * 64 * 4;
constexpr size_t WS_MIX = WS_HB + (size_t)NTOK * 2048 * 2;
constexpr size_t WS_T = WS_MIX + (size_t)NTOK * DM * 2;
constexpr size_t WS_MRG = WS_T + (size_t)NTOK * DM * 4;
constexpr size_t WS_END = WS_MRG + (size_t)NTOK * DM * 2;

struct Params { const float* in[16]; float* out; unsigned char* ws; int ph_lo, ph_hi; };
enum { I_XP = 0, I_XS, I_SC, I_SN, I_SM, I_CK, I_CV, I_WIN, I_BIF, I_NMG, I_SINK, I_WBM, I_WBA, I_WOUT, I_LNG, I_LNB };

DI float bf2f(unsigned b) { return __uint_as_float(b << 16); }
DI float bflo(unsigned w) { return __uint_as_float(w << 16); }
DI float bfhi(unsigned w) { return __uint_as_float(w & 0xffff0000u); }
DI unsigned pk2(float lo, float hi) { return pg8::cvt_pk_bf16(lo, hi); }
DI bf16 f2bf(float f) { return (bf16)(pk2(f, 0.f) & 0xffffu); }
DI float sigm(float x) { return 1.f / (1.f + __expf(-x)); }
DI float wave_sum(float v) {
#pragma unroll
  for (int o = 1; o < 64; o <<= 1) v += __shfl_xor(v, o);
  return v;
}
#define LDS_FENCE() asm volatile("s_waitcnt lgkmcnt(0)" ::: "memory")
#define MFMA16(a, b, c) __builtin_amdgcn_mfma_f32_16x16x32_bf16((a), (b), (c), 0, 0, 0)

DI void tr_item(const float* __restrict__ W, int ldw, int k0, int n0, bf16* __restrict__ WT, int ldt, int trow0, int tcol0, LAS unsigned* scr, int lane) {
  const int l16 = lane & 15, kq = lane >> 4;
  f32x4 v[16];
#pragma unroll
  for (int i = 0; i < 8; ++i) {
    const int k = 8 * i + 2 * kq;
    v[2 * i] = *(const f32x4*)(W + (size_t)(k0 + k) * ldw + n0 + l16 * 4);
    v[2 * i + 1] = *(const f32x4*)(W + (size_t)(k0 + k + 1) * ldw + n0 + l16 * 4);
  }
#pragma unroll
  for (int i = 0; i < 8; ++i) {
    const int kp = 4 * i + kq;
#pragma unroll
    for (int j = 0; j < 4; ++j) scr[(l16 * 4 + j) * 33 + kp] = pk2(v[2 * i][j], v[2 * i + 1][j]);
  }
  LDS_FENCE();
#pragma unroll
  for (int u = 0; u < 8; ++u) {
    const int n = u * 8 + (lane >> 3), kc = lane & 7;
    u32x4 o; o.x = scr[n * 33 + kc * 4]; o.y = scr[n * 33 + kc * 4 + 1]; o.z = scr[n * 33 + kc * 4 + 2]; o.w = scr[n * 33 + kc * 4 + 3];
    *(u32x4*)(WT + (size_t)(trow0 + n) * ldt + tcol0 + kc * 8) = o;
  }
  LDS_FENCE();
}
DI void xcvt_item(const Params& p, int item, int lane) {
  const int rg = item >> 2, kq4 = item & 3, r = lane & 15, q = lane >> 4;
  const int row = rg * 16 + r;
  const float* xr = row < NPR ? p.in[I_XP] + (size_t)row * DM : p.in[I_XS] + (size_t)(row - NPR) * DM;
  const float* wif = p.in[I_WIN] + 10240 + r;
  bf16* xb = (bf16*)(p.ws + WS_XB) + (size_t)row * DM;
  f32x4 acc = {0.f, 0.f, 0.f, 0.f};
#pragma unroll 2
  for (int k0 = kq4 * 1024; k0 < kq4 * 1024 + 1024; k0 += 64) {
    f32x4 xv[4]; float wv[4][4];
#pragma unroll
    for (int u = 0; u < 4; ++u) xv[u] = *(const f32x4*)(xr + k0 + 16 * u + 4 * q);
#pragma unroll
    for (int u = 0; u < 4; ++u)
#pragma unroll
      for (int i = 0; i < 4; ++i) wv[u][i] = wif[(size_t)(k0 + 16 * u + 4 * q + i) * LDW];
#pragma unroll
    for (int u = 0; u < 4; ++u) {
#pragma unroll
      for (int i = 0; i < 4; ++i) acc = __builtin_amdgcn_mfma_f32_16x16x4f32(xv[u][i], wv[u][i], acc, 0, 0, 0);
      u32x2 o; o.x = pk2(xv[u][0], xv[u][1]); o.y = pk2(xv[u][2], xv[u][3]);
      *(u32x2*)(xb + k0 + 16 * u + 4 * q) = o;
    }
  }
  float* g4 = (float*)(p.ws + WS_G4) + (size_t)kq4 * NTOK * 16;
#pragma unroll
  for (int j = 0; j < 4; ++j) g4[(size_t)(rg * 16 + 4 * q + j) * 16 + r] = acc[j];
}
DI void phase0(const Params& p, LAS unsigned char* lds) {
  const int tid = TID(), lane = tid & 63, wave = tid >> 6;
  const int gw = BID() * 8 + wave, NGW = gridDim.x * 8;
  LAS unsigned* scr = (LAS unsigned*)(lds + wave * 8704);
  {
    float* rt = (float*)(p.ws + WS_ROPE);
    for (int i = BID() * 512 + tid; i < NROPE * 32; i += gridDim.x * 512) {
      const int pi = i >> 5, fi = i & 31;
      const int pos = pi < SEQ ? pi : 8192 + (pi - SEQ);
      double inv = 1.0; const double rr = 0.74989420933245582730;
      for (int j = 0; j < fi; ++j) inv *= rr;
      double rev = (double)pos * inv * 0.15915494309189533577;
      rev -= floor(rev);
      const float rf = (float)rev;
      rt[pi * 64 + fi] = __builtin_amdgcn_cosf(rf);
      rt[pi * 64 + 32 + fi] = __builtin_amdgcn_sinf(rf);
    }
  }
  constexpr int N_X = (NTOK / 16) * 4;
  constexpr int N_WIN = 64 * (LDY / 64);
  constexpr int N_WB = 32 * 64, N_WO = 64 * 64;
  constexpr int NITEMS = N_X + N_WIN + 2 * N_WB + N_WO;
  for (int it = gw; it < NITEMS; it += NGW) {
    int r = it;
    if (r < N_X) { xcvt_item(p, r, lane); continue; } r -= N_X;
    if (r < N_WIN) { const int kt = r / (LDY / 64), nt = r % (LDY / 64); const int n0 = nt * 64;
      tr_item(p.in[I_WIN], LDW, kt * 64, n0 < 10240 ? n0 : n0 + 16, (bf16*)(p.ws + WS_WINT), DM, n0, kt * 64, scr, lane); continue; } r -= N_WIN;
    if (r < N_WB) { const int kt = r / 64, nt = r % 64; tr_item(p.in[I_WBM], DM, kt * 64, nt * 64, (bf16*)(p.ws + WS_WBT), DM, nt * 64, kt * 64, scr, lane); continue; } r -= N_WB;
    if (r < N_WB) { const int kt = r / 64, nt = r % 64; tr_item(p.in[I_WBA], DM, kt * 64, nt * 64, (bf16*)(p.ws + WS_WBT), DM, nt * 64, 2048 + kt * 64, scr, lane); continue; } r -= N_WB;
    { const int kt = r / 64, nt = r % 64; tr_item(p.in[I_WOUT], DM, kt * 64, nt * 64, (bf16*)(p.ws + WS_WOT), DM, nt * 64, kt * 64, scr, lane); }
  }
}
constexpr int MP_Q = 0, MP_K = 33792, MP_KT = 67584, MP_CT = 104448, MP_VT = 129792, MP_WVT = 136704, MP_S = 143616, MP_F = 152832;
DI void mlstm_prompt_item(const Params& p, LAS unsigned char* lds, int item) {
  const int tid = TID(), lane = tid & 63, w = tid >> 6, r = lane & 15, q = lane >> 4;
  const int sl = item & 7, h = (item >> 3) & 7, b = item >> 6;
  const bf16* Y1 = (const bf16*)(p.ws + WS_Y1);
  const float* G4 = (const float*)(p.ws + WS_G4);
  bf16* HB = (bf16*)(p.ws + WS_HB);
  LAS float* F = (LAS float*)(lds + MP_F);
  const float bi = p.in[I_BIF][h], bfg = p.in[I_BIF][8 + h];
  for (int i = tid; i < 48 * 264 / 2; i += 512) ((LAS unsigned*)(lds + MP_CT))[i] = 0u;
  for (int i = tid; i < 48 * 72 / 2; i += 512) { const int row = i / 36; ((LAS unsigned*)(lds + MP_VT))[i] = row == 32 ? 0x3f803f80u : 0u; ((LAS unsigned*)(lds + MP_WVT))[i] = 0u; }
  f32x4 st[2][3];
#pragma unroll
  for (int a = 0; a < 2; ++a)
#pragma unroll
    for (int e = 0; e < 3; ++e) st[a][e] = (f32x4){0.f, 0.f, 0.f, 0.f};
  float m_prev = 0.f;
  u32x4 pq[4], pk[4]; unsigned pkt[16]; bf16 pv[4]; float pgi = 0.f, pgf = 0.f;
  const int dp = tid & 127, sg = tid >> 7;
  const int ve = tid & 31, vs = tid >> 5;
  auto issue = [&](int c) {
    const size_t row0 = (size_t)b * SEQ + (size_t)c * 64;
#pragma unroll
    for (int i = 0; i < 4; ++i) { const int id = tid + 512 * i, row = id >> 5, cc = id & 31;
      pq[i] = *(const u32x4*)(Y1 + (row0 + row) * LDY + C_QM + h * 256 + cc * 8);
      pk[i] = *(const u32x4*)(Y1 + (row0 + row) * LDY + C_KM + h * 256 + cc * 8); }
#pragma unroll
    for (int i = 0; i < 16; ++i) pkt[i] = *(const unsigned*)(Y1 + (row0 + sg * 16 + i) * LDY + C_KM + h * 256 + 2 * dp);
#pragma unroll
    for (int i = 0; i < 4; ++i) pv[i] = Y1[(row0 + vs * 4 + i) * LDY + C_VM + h * 256 + sl * 32 + ve];
    if (w == 0) { float si = 0.f, sf = 0.f;
#pragma unroll
      for (int k4 = 0; k4 < 4; ++k4) { si += G4[((size_t)k4 * NTOK + row0 + lane) * 16 + h]; sf += G4[((size_t)k4 * NTOK + row0 + lane) * 16 + 8 + h]; }
      pgi = si; pgf = sf; }
  };
  auto commit = [&]() {
#pragma unroll
    for (int i = 0; i < 4; ++i) { const int id = tid + 512 * i, row = id >> 5, cc = id & 31;
      *(LAS u32x4*)(lds + MP_Q + row * 528 + cc * 16) = pq[i]; *(LAS u32x4*)(lds + MP_K + row * 528 + cc * 16) = pk[i]; }
    { u32x4 a0, a1, b0, b1;
      a0.x = (pkt[0] & 0xffffu) | (pkt[1] << 16); a0.y = (pkt[2] & 0xffffu) | (pkt[3] << 16); a0.z = (pkt[4] & 0xffffu) | (pkt[5] << 16); a0.w = (pkt[6] & 0xffffu) | (pkt[7] << 16);
      a1.x = (pkt[8] & 0xffffu) | (pkt[9] << 16); a1.y = (pkt[10] & 0xffffu) | (pkt[11] << 16); a1.z = (pkt[12] & 0xffffu) | (pkt[13] << 16); a1.w = (pkt[14] & 0xffffu) | (pkt[15] << 16);
      b0.x = (pkt[0] >> 16) | (pkt[1] & 0xffff0000u); b0.y = (pkt[2] >> 16) | (pkt[3] & 0xffff0000u); b0.z = (pkt[4] >> 16) | (pkt[5] & 0xffff0000u); b0.w = (pkt[6] >> 16) | (pkt[7] & 0xffff0000u);
      b1.x = (pkt[8] >> 16) | (pkt[9] & 0xffff0000u); b1.y = (pkt[10] >> 16) | (pkt[11] & 0xffff0000u); b1.z = (pkt[12] >> 16) | (pkt[13] & 0xffff0000u); b1.w = (pkt[14] >> 16) | (pkt[15] & 0xffff0000u);
      LAS unsigned char* kt0 = lds + MP_KT + (2 * dp) * 144 + sg * 32;
      *(LAS u32x4*)(kt0) = a0; *(LAS u32x4*)(kt0 + 16) = a1; *(LAS u32x4*)(kt0 + 144) = b0; *(LAS u32x4*)(kt0 + 160) = b1; }
    { u32x2 o; o.x = (unsigned)pv[0] | ((unsigned)pv[1] << 16); o.y = (unsigned)pv[2] | ((unsigned)pv[3] << 16);
      *(LAS u32x2*)(lds + MP_VT + ve * 144 + vs * 8) = o; }
  };
  issue(0);
  __syncthreads();
  commit();
  float gi = pgi, gf = pgf;
  const int tt = w >> 1, stb = (w & 1) * 2;
  for (int c = 0; c < 32; ++c) {
    const size_t row0 = (size_t)b * SEQ + (size_t)c * 64;
    if (c + 1 < 32) issue(c + 1);
    __syncthreads();
    bf16 og[2][4];
    if (w < 4) {
#pragma unroll
      for (int et = 0; et < 2; ++et)
#pragma unroll
        for (int j = 0; j < 4; ++j) og[et][j] = Y1[(row0 + w * 16 + 4 * q + j) * LDY + C_OM + h * 256 + sl * 32 + et * 16 + r];
    }
    if (w == 0) {
      const float igv = gi + bi; const float xf = gf + bfg;
      const float lfv = fminf(xf, 0.f) - log1pf(__expf(-fabsf(xf)));
      float bc = lfv;
#pragma unroll
      for (int o = 1; o < 64; o <<= 1) { const float t = __shfl_up(bc, o); if (lane >= o) bc += t; }
      float pm = igv - bc;
#pragma unroll
      for (int o = 1; o < 64; o <<= 1) { const float t = __shfl_up(pm, o); if (lane >= o) pm = fmaxf(pm, t); }
      const float a = bc + m_prev, mt = fmaxf(a, bc + pm);
      const float m_new = __shfl(mt, 63), bl = __shfl(bc, 63);
      F[lane] = bc; F[64 + lane] = igv; F[128 + lane] = mt; F[192 + lane] = __expf(a - mt); F[256 + lane] = __expf(bl - bc + igv - m_new) * 0.0625f;
      if (lane == 0) F[384] = __expf(bl + m_prev - m_new);
      m_prev = m_new;
    }
    f32x4 sa[2] = {(f32x4){0.f, 0.f, 0.f, 0.f}, (f32x4){0.f, 0.f, 0.f, 0.f}};
#pragma unroll
    for (int ks = 0; ks < 8; ++ks) {
      const bf16x8 af = *(const LAS bf16x8*)(lds + MP_Q + (tt * 16 + r) * 528 + ks * 64 + q * 16);
#pragma unroll
      for (int j = 0; j < 2; ++j) if (stb + j <= tt) {
        const bf16x8 bfr = *(const LAS bf16x8*)(lds + MP_K + ((stb + j) * 16 + r) * 528 + ks * 64 + q * 16);
        sa[j] = MFMA16(af, bfr, sa[j]); }
    }
    __syncthreads();
#pragma unroll
    for (int j = 0; j < 2; ++j) {
      const int s = (stb + j) * 16 + r; const float bs = F[s], is = F[64 + s];
#pragma unroll
      for (int g = 0; g < 4; ++g) { const int t = tt * 16 + 4 * q + g;
        const float v = (s <= t) ? sa[j][g] * 0.0625f * __expf(F[t] - bs + is - F[128 + t]) : 0.f;
        *(LAS bf16*)(lds + MP_S + t * 144 + s * 2) = f2bf(v); }
    }
    {
      const u32x2 vv = *(const LAS u32x2*)(lds + MP_VT + ve * 144 + vs * 8);
      const float w0 = F[256 + vs * 4], w1 = F[256 + vs * 4 + 1], w2 = F[256 + vs * 4 + 2], w3 = F[256 + vs * 4 + 3];
      u32x2 o; o.x = pk2(bflo(vv.x) * w0, bfhi(vv.x) * w1); o.y = pk2(bflo(vv.y) * w2, bfhi(vv.y) * w3);
      *(LAS u32x2*)(lds + MP_WVT + ve * 144 + vs * 8) = o;
      if (tid < 64) *(LAS bf16*)(lds + MP_WVT + 32 * 144 + tid * 2) = f2bf(F[256 + tid]);
    }
    __syncthreads();
    f32x4 nS[2] = {(f32x4){0.f, 0.f, 0.f, 0.f}, (f32x4){0.f, 0.f, 0.f, 0.f}}, nC[2] = {(f32x4){0.f, 0.f, 0.f, 0.f}, (f32x4){0.f, 0.f, 0.f, 0.f}};
    const int t4 = w & 3, e0 = (w < 4) ? 0 : 2, ne = (w < 4) ? 2 : 1;
#pragma unroll
    for (int ks = 0; ks < 2; ++ks) {
      const bf16x8 af = *(const LAS bf16x8*)(lds + MP_S + (t4 * 16 + r) * 144 + ks * 64 + q * 16);
#pragma unroll
      for (int j = 0; j < 2; ++j) if (j < ne) { const bf16x8 bfr = *(const LAS bf16x8*)(lds + MP_VT + ((e0 + j) * 16 + r) * 144 + ks * 64 + q * 16); nS[j] = MFMA16(af, bfr, nS[j]); }
    }
#pragma unroll
    for (int ks = 0; ks < 8; ++ks) {
      const bf16x8 af = *(const LAS bf16x8*)(lds + MP_Q + (t4 * 16 + r) * 528 + ks * 64 + q * 16);
#pragma unroll
      for (int j = 0; j < 2; ++j) if (j < ne) { const bf16x8 bfr = *(const LAS bf16x8*)(lds + MP_CT + ((e0 + j) * 16 + r) * 528 + ks * 64 + q * 16); nC[j] = MFMA16(af, bfr, nC[j]); }
    }
    float num[2][4];
#pragma unroll
    for (int j = 0; j < 2; ++j)
#pragma unroll
      for (int g = 0; g < 4; ++g) num[j][g] = nS[j][g] + F[192 + t4 * 16 + 4 * q + g] * nC[j][g];
    if (w >= 4 && r == 0) {
#pragma unroll
      for (int g = 0; g < 4; ++g) F[320 + t4 * 16 + 4 * q + g] = num[0][g];
    }
    { const float dec = F[384];
#pragma unroll
      for (int a = 0; a < 2; ++a)
#pragma unroll
        for (int e = 0; e < 3; ++e) st[a][e] *= dec;
#pragma unroll
      for (int ks = 0; ks < 2; ++ks) {
        bf16x8 bw[3];
#pragma unroll
        for (int e = 0; e < 3; ++e) bw[e] = *(const LAS bf16x8*)(lds + MP_WVT + (e * 16 + r) * 144 + ks * 64 + q * 16);
#pragma unroll
        for (int a = 0; a < 2; ++a) { const bf16x8 af = *(const LAS bf16x8*)(lds + MP_KT + ((2 * w + a) * 16 + r) * 144 + ks * 64 + q * 16);
#pragma unroll
          for (int e = 0; e < 3; ++e) st[a][e] = MFMA16(af, bw[e], st[a][e]); }
      }
    }
    __syncthreads();
    if (w < 4) {
#pragma unroll
      for (int g = 0; g < 4; ++g) { const int t = t4 * 16 + 4 * q + g; const float dn = fmaxf(fabsf(F[320 + t]), __expf(-F[128 + t])), rd = 1.f / dn;
#pragma unroll
        for (int j = 0; j < 2; ++j) HB[(row0 + t) * 2048 + h * 256 + sl * 32 + j * 16 + r] = f2bf(sigm(bf2f(og[j][g])) * num[j][g] * rd); }
    }
#pragma unroll
    for (int a = 0; a < 2; ++a)
#pragma unroll
      for (int e = 0; e < 3; ++e) { u32x2 o; o.x = pk2(st[a][e][0], st[a][e][1]); o.y = pk2(st[a][e][2], st[a][e][3]);
        *(LAS u32x2*)(lds + MP_CT + (e * 16 + r) * 528 + ((2 * w + a) * 16 + 4 * q) * 2) = o; }
    if (c + 1 < 32) { commit(); gi = pgi; gf = pgf; }
  }
  float* oC = p.out + O_PC + (size_t)(b * 8 + h) * 65536;
#pragma unroll
  for (int a = 0; a < 2; ++a)
#pragma unroll
    for (int g = 0; g < 4; ++g) { const int d = (2 * w + a) * 16 + 4 * q + g;
      oC[(size_t)d * 256 + sl * 32 + r] = st[a][0][g]; oC[(size_t)d * 256 + sl * 32 + 16 + r] = st[a][1][g];
      if (sl == 0 && r == 0) p.out[O_PN + (size_t)(b * 8 + h) * 256 + d] = st[a][2][g]; }
  if (sl == 0 && tid == 0) p.out[O_PM + b * 8 + h] = m_prev;
  __syncthreads();
}
DI void mlstm_sample_item(const Params& p, LAS unsigned char* lds, int item) {
  const int tid = TID(), lane = tid & 63, w = tid >> 6;
  const int h = item & 7, b = item >> 3;
  const bf16* Y1 = (const bf16*)(p.ws + WS_Y1);
  const float* G4 = (const float*)(p.ws + WS_G4);
  bf16* HB = (bf16*)(p.ws + WS_HB);
  LAS float* qs = (LAS float*)lds; LAS float* ks = (LAS float*)(lds + 8192); LAS float* vs = (LAS float*)(lds + 16384);
  LAS float* red = (LAS float*)(lds + 24576); LAS float* n0 = (LAS float*)(lds + 90112);
  LAS float* M = (LAS float*)(lds + 91136);
  const size_t row0 = (size_t)NPR + (size_t)b * 8;
  { const int t = tid >> 6, c4 = (tid & 63) * 4;
    const u32x2 a = *(const u32x2*)(Y1 + (row0 + t) * LDY + C_QM + h * 256 + c4);
    const u32x2 k2 = *(const u32x2*)(Y1 + (row0 + t) * LDY + C_KM + h * 256 + c4);
    const u32x2 v2 = *(const u32x2*)(Y1 + (row0 + t) * LDY + C_VM + h * 256 + c4);
    *(LAS f32x4*)(qs + t * 256 + c4) = (f32x4){bflo(a.x), bfhi(a.x), bflo(a.y), bfhi(a.y)};
    *(LAS f32x4*)(ks + t * 256 + c4) = (f32x4){bflo(k2.x) * 0.0625f, bfhi(k2.x) * 0.0625f, bflo(k2.y) * 0.0625f, bfhi(k2.y) * 0.0625f};
    *(LAS f32x4*)(vs + t * 256 + c4) = (f32x4){bflo(v2.x), bfhi(v2.x), bflo(v2.y), bfhi(v2.y)};
    if (tid < 256) n0[tid] = p.in[I_SN][(size_t)item * 256 + tid];
    if (tid < 8) { float si = 0.f, sf = 0.f;
      for (int k4 = 0; k4 < 4; ++k4) { si += G4[((size_t)k4 * NTOK + row0 + tid) * 16 + h]; sf += G4[((size_t)k4 * NTOK + row0 + tid) * 16 + 8 + h]; }
      const float xf = sf + p.in[I_BIF][8 + h];
      M[tid] = si + p.in[I_BIF][h]; M[8 + tid] = fminf(xf, 0.f) - log1pf(__expf(-fabsf(xf))); }
  }
  __syncthreads();
  if (tid == 0) {
    const float m0 = p.in[I_SM][item];
    float bc = 0.f, pm = -3.0e38f;
    for (int t = 0; t < 8; ++t) { bc += M[8 + t]; M[128 + t] = bc; pm = fmaxf(pm, M[t] - bc); const float a = bc + m0, mt = fmaxf(a, bc + pm); M[16 + t] = mt; M[24 + t] = __expf(a - mt); }
    const float m_new = M[16 + 7], bl = M[128 + 7];
    for (int s = 0; s < 8; ++s) M[32 + s] = __expf(bl - M[128 + s] + M[s] - m_new);
    M[40] = __expf(bl + m0 - m_new); M[41] = m_new;
  }
  __syncthreads();
  {
    const int t = w; const f32x4 qv = *(const LAS f32x4*)(qs + t * 256 + lane * 4);
    for (int s = 0; s < 8; ++s) {
      const f32x4 kv = *(const LAS f32x4*)(ks + s * 256 + lane * 4);
      const float d = wave_sum(qv[0] * kv[0] + qv[1] * kv[1] + qv[2] * kv[2] + qv[3] * kv[3]);
      if (lane == 0) M[64 + t * 8 + s] = (s <= t) ? d * __expf(M[128 + t] - M[128 + s] + M[s] - M[16 + t]) : 0.f;
    }
    const f32x4 nv = *(const LAS f32x4*)(n0 + lane * 4);
    const float d = wave_sum(qv[0] * nv[0] + qv[1] * nv[1] + qv[2] * nv[2] + qv[3] * nv[3]);
    if (lane == 0) M[48 + t] = d;
  }
  const float decay = M[40];
  const int e4 = lane * 4;
  f32x4 wv[8], num[8];
#pragma unroll
  for (int s = 0; s < 8; ++s) { wv[s] = *(const LAS f32x4*)(vs + s * 256 + e4) * M[32 + s]; num[s] = (f32x4){0.f, 0.f, 0.f, 0.f}; }
  const float* C0 = p.in[I_SC] + (size_t)item * 65536;
  float* C1 = p.out + O_SC + (size_t)item * 65536;
#pragma unroll 4
  for (int i = 0; i < 32; ++i) {
    const int d = w + 8 * i;
    const f32x4 c4 = __builtin_nontemporal_load((const f32x4*)(C0 + (size_t)d * 256 + e4));
    f32x4 cn = c4 * decay;
#pragma unroll
    for (int t = 0; t < 8; ++t) { const float qd = qs[t * 256 + d], kd = ks[t * 256 + d]; num[t] += c4 * qd; cn += wv[t] * kd; }
    __builtin_nontemporal_store(cn, (f32x4*)(C1 + (size_t)d * 256 + e4));
  }
#pragma unroll
  for (int t = 0; t < 8; ++t) *(LAS f32x4*)(red + (w * 8 + t) * 256 + e4) = num[t];
  __syncthreads();
  { const int t = w;
    f32x4 nc = {0.f, 0.f, 0.f, 0.f};
#pragma unroll
    for (int w2 = 0; w2 < 8; ++w2) nc += *(const LAS f32x4*)(red + (w2 * 8 + t) * 256 + e4);
    f32x4 sv = {0.f, 0.f, 0.f, 0.f}; float ss = 0.f;
#pragma unroll
    for (int s = 0; s < 8; ++s) { const float S = M[64 + t * 8 + s]; sv += *(const LAS f32x4*)(vs + s * 256 + e4) * S; ss += S; }
    const float inter = M[24 + t], den = ss + inter * M[48 + t], dn = fmaxf(fabsf(den), __expf(-M[16 + t])), rd = 1.f / dn;
    const u32x2 o2 = *(const u32x2*)(Y1 + (row0 + t) * LDY + C_OM + h * 256 + e4);
    const f32x4 hv = (sv + nc * inter) * rd;
    u32x2 o; o.x = pk2(sigm(bflo(o2.x)) * hv[0], sigm(bfhi(o2.x)) * hv[1]); o.y = pk2(sigm(bflo(o2.y)) * hv[2], sigm(bfhi(o2.y)) * hv[3]);
    *(u32x2*)(HB + (row0 + t) * 2048 + h * 256 + e4) = o;
  }
  if (tid < 256) { float nn = decay * n0[tid];
#pragma unroll
    for (int s = 0; s < 8; ++s) nn += M[32 + s] * ks[s * 256 + tid];
    p.out[O_SN + (size_t)item * 256 + tid] = nn; }
  if (tid == 0) p.out[O_SM + item] = M[41];
  __syncthreads();
}

constexpr int AT_K = 0, AT_VT = 23040, AT_END = 23040 + 64 * 336;
DI void attn_wave(const LAS unsigned char* lds, bf16x8 qf0, bf16x8 qf1, int klo, int khi, float sink, f32x4 (&o)[4]) {
  const int lane = TID() & 63, r = lane & 15, q = lane >> 4;
  f32x4 s[10];
#pragma unroll
  for (int kt = 0; kt < 10; ++kt) {
    const bf16x8 a0 = *(const LAS bf16x8*)(lds + AT_K + (kt * 16 + r) * 144 + q * 16), a1 = *(const LAS bf16x8*)(lds + AT_K + (kt * 16 + r) * 144 + 64 + q * 16);
    f32x4 acc = {0.f, 0.f, 0.f, 0.f};
    acc = MFMA16(a0, qf0, acc); acc = MFMA16(a1, qf1, acc);
    s[kt] = acc;
  }
  float mx = sink;
#pragma unroll
  for (int kt = 0; kt < 10; ++kt)
#pragma unroll
    for (int g = 0; g < 4; ++g) { const int j = kt * 16 + 4 * q + g; const bool ok = (j >= klo) && (j <= khi); s[kt][g] = ok ? s[kt][g] * 0.125f : -3.0e38f; mx = fmaxf(mx, s[kt][g]); }
  mx = fmaxf(mx, __shfl_xor(mx, 16)); mx = fmaxf(mx, __shfl_xor(mx, 32));
  float sum = 0.f;
#pragma unroll
  for (int kt = 0; kt < 10; ++kt)
#pragma unroll
    for (int g = 0; g < 4; ++g) { const float pv = s[kt][g] > -1.0e38f ? __expf(s[kt][g] - mx) : 0.f; s[kt][g] = pv; sum += pv; }
  sum += __shfl_xor(sum, 16); sum += __shfl_xor(sum, 32);
  const float rden = 1.f / (sum + __expf(sink - mx));
#pragma unroll
  for (int dt = 0; dt < 4; ++dt) o[dt] = (f32x4){0.f, 0.f, 0.f, 0.f};
#pragma unroll
  for (int u = 0; u < 5; ++u) {
    u32x4 pw; pw.x = pk2(s[2 * u][0], s[2 * u][1]); pw.y = pk2(s[2 * u][2], s[2 * u][3]); pw.z = pk2(s[2 * u + 1][0], s[2 * u + 1][1]); pw.w = pk2(s[2 * u + 1][2], s[2 * u + 1][3]);
    const bf16x8 pb = __builtin_bit_cast(bf16x8, pw);
#pragma unroll
    for (int dt = 0; dt < 4; ++dt) {
      const u32x2 lo = *(const LAS u32x2*)(lds + AT_VT + (dt * 16 + r) * 336 + (u * 32 + 4 * q) * 2), hi = *(const LAS u32x2*)(lds + AT_VT + (dt * 16 + r) * 336 + (u * 32 + 16 + 4 * q) * 2);
      u32x4 aw; aw.x = lo.x; aw.y = lo.y; aw.z = hi.x; aw.w = hi.y;
      o[dt] = MFMA16(__builtin_bit_cast(bf16x8, aw), pb, o[dt]);
    }
  }
#pragma unroll
  for (int dt = 0; dt < 4; ++dt) o[dt] *= rden;
}
DI void rope8(const u32x4 x1, const u32x4 x2, const float* rt, int i0, float (&o1)[8], float (&o2)[8]) {
  const f32x4 c0 = *(const f32x4*)(rt + i0), c1 = *(const f32x4*)(rt + i0 + 4), s0 = *(const f32x4*)(rt + 32 + i0), s1 = *(const f32x4*)(rt + 32 + i0 + 4);
  const float a[8] = {bflo(x1.x), bfhi(x1.x), bflo(x1.y), bfhi(x1.y), bflo(x1.z), bfhi(x1.z), bflo(x1.w), bfhi(x1.w)};
  const float bb[8] = {bflo(x2.x), bfhi(x2.x), bflo(x2.y), bfhi(x2.y), bflo(x2.z), bfhi(x2.z), bflo(x2.w), bfhi(x2.w)};
  const float cs[8] = {c0[0], c0[1], c0[2], c0[3], c1[0], c1[1], c1[2], c1[3]}, sn[8] = {s0[0], s0[1], s0[2], s0[3], s1[0], s1[1], s1[2], s1[3]};
#pragma unroll
  for (int j = 0; j < 8; ++j) { o1[j] = a[j] * cs[j] - bb[j] * sn[j]; o2[j] = bb[j] * cs[j] + a[j] * sn[j]; }
}
DI u32x4 pack8(const float (&v)[8]) { u32x4 o; o.x = pk2(v[0], v[1]); o.y = pk2(v[2], v[3]); o.z = pk2(v[4], v[5]); o.w = pk2(v[6], v[7]); return o; }
DI void attn_store(const Params& p, const f32x4 (&o)[4], size_t row, int head) {
  const int lane = TID() & 63, q = lane >> 4;
  const bf16* Y1 = (const bf16*)(p.ws + WS_Y1); bf16* MIX = (bf16*)(p.ws + WS_MIX);
#pragma unroll
  for (int dt = 0; dt < 4; ++dt) {
    const u32x2 z = *(const u32x2*)(Y1 + row * LDY + C_ZA + head * 64 + dt * 16 + 4 * q);
    const float z0 = bflo(z.x), z1 = bfhi(z.x), z2 = bflo(z.y), z3 = bfhi(z.y);
    u32x2 w; w.x = pk2(o[dt][0] * z0 * sigm(z0), o[dt][1] * z1 * sigm(z1)); w.y = pk2(o[dt][2] * z2 * sigm(z2), o[dt][3] * z3 * sigm(z3));
    *(u32x2*)(MIX + row * DM + 2048 + head * 64 + dt * 16 + 4 * q) = w;
  }
}
DI void attn_prompt_item(const Params& p, LAS unsigned char* lds, int item) {
  const int tid = TID(), lane = tid & 63, w = tid >> 6, r = lane & 15, q = lane >> 4;
  const int kvh = item & 7, qb = (item >> 3) & 63, b = item >> 9, q0 = qb * 32;
  const bf16* Y1 = (const bf16*)(p.ws + WS_Y1); const float* RT = (const float*)(p.ws + WS_ROPE);
  const size_t rowb = (size_t)b * SEQ;
  for (int task = tid; task < 640; task += 512) {
    const int j = task >> 2, c4 = task & 3, pos = q0 - 128 + j;
    u32x4 w1 = {0u, 0u, 0u, 0u}, w2 = {0u, 0u, 0u, 0u};
    if (pos >= 0) {
      const bf16* src = Y1 + (rowb + pos) * LDY + C_KA + kvh * 64 + c4 * 8;
      float o1[8], o2[8]; rope8(*(const u32x4*)src, *(const u32x4*)(src + 32), RT + pos * 64, c4 * 8, o1, o2);
      w1 = pack8(o1); w2 = pack8(o2);
      if (pos >= SEQ - 128 && j >= 128) { float* dst = p.out + O_PK + (((size_t)b * 128 + (pos - (SEQ - 128))) * 8 + kvh) * 64 + c4 * 8;
        *(f32x4*)dst = (f32x4){o1[0], o1[1], o1[2], o1[3]}; *(f32x4*)(dst + 4) = (f32x4){o1[4], o1[5], o1[6], o1[7]};
        *(f32x4*)(dst + 32) = (f32x4){o2[0], o2[1], o2[2], o2[3]}; *(f32x4*)(dst + 36) = (f32x4){o2[4], o2[5], o2[6], o2[7]}; }
    }
    *(LAS u32x4*)(lds + AT_K + j * 144 + c4 * 16) = w1; *(LAS u32x4*)(lds + AT_K + j * 144 + 64 + c4 * 16) = w2;
  }
  for (int task = tid; task < 640; task += 512) {
    const int dpp = task & 31, kg = task >> 5;
    unsigned v[8];
#pragma unroll
    for (int i = 0; i < 8; ++i) { const int pos = q0 - 128 + kg * 8 + i; v[i] = pos >= 0 ? *(const unsigned*)(Y1 + (rowb + pos) * LDY + C_VA + kvh * 64 + 2 * dpp) : 0u;
      if (pos >= SEQ - 128 && kg >= 16) *(f32x2*)(p.out + O_PV + (((size_t)b * 128 + (pos - (SEQ - 128))) * 8 + kvh) * 64 + 2 * dpp) = (f32x2){bflo(v[i]), bfhi(v[i])}; }
    u32x4 a, bq;
    a.x = (v[0] & 0xffffu) | (v[1] << 16); a.y = (v[2] & 0xffffu) | (v[3] << 16); a.z = (v[4] & 0xffffu) | (v[5] << 16); a.w = (v[6] & 0xffffu) | (v[7] << 16);
    bq.x = (v[0] >> 16) | (v[1] & 0xffff0000u); bq.y = (v[2] >> 16) | (v[3] & 0xffff0000u); bq.z = (v[4] >> 16) | (v[5] & 0xffff0000u); bq.w = (v[6] >> 16) | (v[7] & 0xffff0000u);
    *(LAS u32x4*)(lds + AT_VT + (2 * dpp) * 336 + kg * 16) = a; *(LAS u32x4*)(lds + AT_VT + (2 * dpp + 1) * 336 + kg * 16) = bq;
  }
  const int g = w >> 1, qt = w & 1, head = kvh * 4 + g, qpos = q0 + qt * 16 + r;
  bf16x8 qf0, qf1;
  { const bf16* src = Y1 + (rowb + qpos) * LDY + C_QA + head * 64 + q * 8;
    float o1[8], o2[8]; rope8(*(const u32x4*)src, *(const u32x4*)(src + 32), RT + qpos * 64, q * 8, o1, o2);
    qf0 = __builtin_bit_cast(bf16x8, pack8(o1)); qf1 = __builtin_bit_cast(bf16x8, pack8(o2)); }
  __syncthreads();
  f32x4 o[4];
  const int klo0 = qt * 16 + r + 1, kmin = 128 - q0;
  attn_wave(lds, qf0, qf1, klo0 > kmin ? klo0 : kmin, qt * 16 + r + 128, p.in[I_SINK][head], o);
  attn_store(p, o, rowb + qpos, head);
  __syncthreads();
}
DI void attn_sample_item(const Params& p, LAS unsigned char* lds, int item) {
  const int tid = TID(), lane = tid & 63, w = tid >> 6, r = lane & 15, q = lane >> 4;
  const int kvh = item & 7, b = item >> 3;
  const bf16* Y1 = (const bf16*)(p.ws + WS_Y1); const float* RT = (const float*)(p.ws + WS_ROPE);
  const size_t rowb = (size_t)NPR + (size_t)b * 8;
  const float* CK = p.in[I_CK] + (size_t)b * 128 * 512 + kvh * 64; const float* CV = p.in[I_CV] + (size_t)b * 128 * 512 + kvh * 64;
  float* OK = p.out + O_SK + (size_t)b * 128 * 512 + kvh * 64; float* OV = p.out + O_SV + (size_t)b * 128 * 512 + kvh * 64;
  for (int task = tid; task < 640; task += 512) {
    const int j = task >> 2, c4 = task & 3;
    u32x4 w1 = {0u, 0u, 0u, 0u}, w2 = {0u, 0u, 0u, 0u};
    float o1[8], o2[8]; bool have = false;
    if (j < 128) { const float* src = CK + (size_t)j * 512 + c4 * 8;
      const f32x4 a0 = *(const f32x4*)src, a1 = *(const f32x4*)(src + 4), b0 = *(const f32x4*)(src + 32), b1 = *(const f32x4*)(src + 36);
#pragma unroll
      for (int i = 0; i < 4; ++i) { o1[i] = a0[i]; o1[4 + i] = a1[i]; o2[i] = b0[i]; o2[4 + i] = b1[i]; }
      have = true;
    } else if (j < 136) { const int t = j - 128; const bf16* src = Y1 + (rowb + t) * LDY + C_KA + kvh * 64 + c4 * 8;
      rope8(*(const u32x4*)src, *(const u32x4*)(src + 32), RT + (SEQ + t) * 64, c4 * 8, o1, o2); have = true; }
    if (have) { w1 = pack8(o1); w2 = pack8(o2);
      if (j >= 8) { float* dst = OK + (size_t)(j - 8) * 512 + c4 * 8;
        *(f32x4*)dst = (f32x4){o1[0], o1[1], o1[2], o1[3]}; *(f32x4*)(dst + 4) = (f32x4){o1[4], o1[5], o1[6], o1[7]};
        *(f32x4*)(dst + 32) = (f32x4){o2[0], o2[1], o2[2], o2[3]}; *(f32x4*)(dst + 36) = (f32x4){o2[4], o2[5], o2[6], o2[7]}; } }
    *(LAS u32x4*)(lds + AT_K + j * 144 + c4 * 16) = w1; *(LAS u32x4*)(lds + AT_K + j * 144 + 64 + c4 * 16) = w2;
  }
  for (int task = tid; task < 640; task += 512) {
    const int dpp = task & 31, kg = task >> 5;
    float v0[8], v1[8];
#pragma unroll
    for (int i = 0; i < 8; ++i) { const int j = kg * 8 + i; v0[i] = 0.f; v1[i] = 0.f;
      if (kg < 16) { const f32x2 t2 = *(const f32x2*)(CV + (size_t)j * 512 + 2 * dpp); v0[i] = t2.x; v1[i] = t2.y; }
      else if (kg == 16) { const unsigned t2 = *(const unsigned*)(Y1 + (rowb + i) * LDY + C_VA + kvh * 64 + 2 * dpp); v0[i] = bflo(t2); v1[i] = bfhi(t2); }
      if (j >= 8 && j < 136) *(f32x2*)(OV + (size_t)(j - 8) * 512 + 2 * dpp) = (f32x2){v0[i], v1[i]}; }
    *(LAS u32x4*)(lds + AT_VT + (2 * dpp) * 336 + kg * 16) = pack8(v0); *(LAS u32x4*)(lds + AT_VT + (2 * dpp + 1) * 336 + kg * 16) = pack8(v1);
  }
  __syncthreads();
  if (w < 2) {
    const int g = 2 * w + (r >> 3), t = r & 7, head = kvh * 4 + g;
    bf16x8 qf0, qf1;
    { const bf16* src = Y1 + (rowb + t) * LDY + C_QA + head * 64 + q * 8;
      float o1[8], o2[8]; rope8(*(const u32x4*)src, *(const u32x4*)(src + 32), RT + (SEQ + t) * 64, q * 8, o1, o2);
      qf0 = __builtin_bit_cast(bf16x8, pack8(o1)); qf1 = __builtin_bit_cast(bf16x8, pack8(o2)); }
    f32x4 o[4];
    attn_wave(lds, qf0, qf1, t + 1, t + 128, p.in[I_SINK][head], o);
    attn_store(p, o, rowb + t, head);
  }
  __syncthreads();
}
DI void phase_mixers(const Params& p, LAS unsigned char* lds) {
#ifndef ONLYIT
#define ONLYIT -1
#endif
#define ITON(k) (ONLYIT == -1 || ONLYIT == (k))
  if constexpr (ITON(0)) for (int it = BID(); it < 256; it += gridDim.x) mlstm_prompt_item(p, lds, it);
  constexpr int N_MS = 1024, N_AP = 4 * 64 * 8, N_AS = 1024;
  for (int it = BID(); it < N_MS + N_AP + N_AS; it += gridDim.x) {
    if (it < N_MS) { if constexpr (ITON(1)) mlstm_sample_item(p, lds, it); }
    else if (it < N_MS + N_AP) { if constexpr (ITON(2)) attn_prompt_item(p, lds, it - N_MS); }
    else { if constexpr (ITON(3)) attn_sample_item(p, lds, it - N_MS - N_AP); }
  }
}
DI void phase_headnorm(const Params& p) {
  const int lane = TID() & 63, gw = BID() * 8 + (TID() >> 6), NGW = gridDim.x * 8;
  const bf16* Y1 = (const bf16*)(p.ws + WS_Y1); const bf16* HB = (const bf16*)(p.ws + WS_HB); bf16* MIX = (bf16*)(p.ws + WS_MIX);
  for (int it = gw; it < NTOK * 8; it += NGW) {
    const int row = it >> 3, h = it & 7;
    const u32x2 hv = *(const u32x2*)(HB + (size_t)row * 2048 + h * 256 + lane * 4);
    const u32x2 zv = *(const u32x2*)(Y1 + (size_t)row * LDY + C_ZM + h * 256 + lane * 4);
    const f32x4 g = *(const f32x4*)(p.in[I_NMG] + h * 256 + lane * 4);
    float x[4] = {bflo(hv.x), bfhi(hv.x), bflo(hv.y), bfhi(hv.y)};
    const float z[4] = {bflo(zv.x), bfhi(zv.x), bflo(zv.y), bfhi(zv.y)};
    const float mu = wave_sum((x[0] + x[1]) + (x[2] + x[3])) * (1.f / 256.f);
    float s2 = 0.f;
#pragma unroll
    for (int j = 0; j < 4; ++j) { x[j] -= mu; s2 += x[j] * x[j]; }
    const float rstd = 1.f / sqrtf(wave_sum(s2) * (1.f / 256.f) + 1e-5f);
    float o[4];
#pragma unroll
    for (int j = 0; j < 4; ++j) o[j] = x[j] * rstd * g[j] * z[j] * sigm(z[j]);
    u32x2 w; w.x = pk2(o[0], o[1]); w.y = pk2(o[2], o[3]);
    *(u32x2*)(MIX + (size_t)row * DM + h * 256 + lane * 4) = w;
  }
}
DI void phase_ln(const Params& p) {
  const int lane = TID() & 63, gw = BID() * 8 + (TID() >> 6), NGW = gridDim.x * 8;
  for (int row = gw; row < NTOK; row += NGW) {
    float* y = p.out + (size_t)row * DM;
    f32x4 v[16]; float s = 0.f;
#pragma unroll
    for (int j = 0; j < 16; ++j) { v[j] = *(const f32x4*)(y + j * 256 + lane * 4); s += (v[j][0] + v[j][1]) + (v[j][2] + v[j][3]); }
    const float mu = wave_sum(s) * (1.f / DM); float s2 = 0.f;
#pragma unroll
    for (int j = 0; j < 16; ++j) { v[j] = v[j] - mu; s2 += (v[j][0] * v[j][0] + v[j][1] * v[j][1]) + (v[j][2] * v[j][2] + v[j][3] * v[j][3]); }
    const float rstd = 1.f / sqrtf(wave_sum(s2) * (1.f / DM) + 1e-5f);
#pragma unroll
    for (int j = 0; j < 16; ++j) { const f32x4 g = *(const f32x4*)(p.in[I_LNG] + j * 256 + lane * 4), bb = *(const f32x4*)(p.in[I_LNB] + j * 256 + lane * 4);
      *(f32x4*)(y + j * 256 + lane * 4) = v[j] * rstd * g + bb; }
  }
}
struct EpiGateM {
  static constexpr bool PERM = true, AFTER_DRAIN = false;
  float* T; const bf16* Y1;
  DI void operator()(const f32x4 (&acc)[2][2][4][2], const pg8::Unit& u, int wr, int wc, int fr, int fq) const {
    const int row0 = u.pm * 256 + wr * 64 + fr, col0 = u.pn * 256 + wc * 32 + 8 * fq;
#pragma unroll
    for (int ai = 0; ai < 2; ++ai)
#pragma unroll
      for (int m = 0; m < 4; ++m) { const size_t row = row0 + ai * 128 + m * 16;
#pragma unroll
        for (int bj = 0; bj < 2; ++bj) { const int col = col0 + bj * 128;
          const u32x4 g = *(const u32x4*)(Y1 + row * LDY + C_GM + col);
          const f32x4 v0 = acc[ai][bj][m][0], v1 = acc[ai][bj][m][1];
          *(f32x4*)(T + row * DM + col) = (f32x4){sigm(bflo(g.x)) * v0[0], sigm(bfhi(g.x)) * v0[1], sigm(bflo(g.y)) * v0[2], sigm(bfhi(g.y)) * v0[3]};
          *(f32x4*)(T + row * DM + col + 4) = (f32x4){sigm(bflo(g.z)) * v1[0], sigm(bfhi(g.z)) * v1[1], sigm(bflo(g.w)) * v1[2], sigm(bfhi(g.w)) * v1[3]}; } }
  }
};
struct EpiGateA {
  static constexpr bool PERM = true, AFTER_DRAIN = false;
  const float* T; const bf16* Y1; bf16* O;
  DI void operator()(const f32x4 (&acc)[2][2][4][2], const pg8::Unit& u, int wr, int wc, int fr, int fq) const {
    const int row0 = u.pm * 256 + wr * 64 + fr, col0 = u.pn * 256 + wc * 32 + 8 * fq;
#pragma unroll
    for (int ai = 0; ai < 2; ++ai)
#pragma unroll
      for (int m = 0; m < 4; ++m) { const size_t row = row0 + ai * 128 + m * 16;
#pragma unroll
        for (int bj = 0; bj < 2; ++bj) { const int col = col0 + bj * 128;
          const u32x4 g = *(const u32x4*)(Y1 + row * LDY + C_GA + col);
          const f32x4 t0 = *(const f32x4*)(T + row * DM + col), t1 = *(const f32x4*)(T + row * DM + col + 4);
          const f32x4 v0 = acc[ai][bj][m][0], v1 = acc[ai][bj][m][1];
          u32x4 w; w.x = pk2(t0[0] + sigm(bflo(g.x)) * v0[0], t0[1] + sigm(bfhi(g.x)) * v0[1]); w.y = pk2(t0[2] + sigm(bflo(g.y)) * v0[2], t0[3] + sigm(bfhi(g.y)) * v0[3]);
          w.z = pk2(t1[0] + sigm(bflo(g.z)) * v1[0], t1[1] + sigm(bfhi(g.z)) * v1[1]); w.w = pk2(t1[2] + sigm(bflo(g.w)) * v1[2], t1[3] + sigm(bfhi(g.w)) * v1[3]);
          *(u32x4*)(O + row * DM + col) = w; } }
  }
};
struct EpiOut {
  static constexpr bool PERM = false, AFTER_DRAIN = false;
  const float* xp; const float* xs; float* out;
  DI void operator()(const f32x4 (&acc)[2][2][4][2], const pg8::Unit& u, int wr, int wc, int fr, int fq) const {
    const int row0 = u.pm * 256 + wr * 64 + fr, col0 = u.pn * 256 + wc * 32 + 4 * fq;
    const float alpha = 1.18920711500272106672f;
#pragma unroll
    for (int ai = 0; ai < 2; ++ai)
#pragma unroll
      for (int m = 0; m < 4; ++m) { const size_t row = row0 + ai * 128 + m * 16;
        const float* xr = row < NPR ? xp + row * DM : xs + (row - NPR) * DM;
#pragma unroll
        for (int bj = 0; bj < 2; ++bj)
#pragma unroll
          for (int n = 0; n < 2; ++n) { const int col = col0 + bj * 128 + n * 16;
            const f32x4 xv = *(const f32x4*)(xr + col);
            *(f32x4*)(out + row * DM + col) = xv * alpha + acc[ai][bj][m][n]; } }
  }
};
constexpr int NPHASES = 8;
__global__ void __launch_bounds__(512) mega(Params p) {
  extern __shared__ __attribute__((aligned(16))) unsigned char lds_raw[];
  LAS unsigned char* lds = (LAS unsigned char*)lds_raw;
  cg::grid_group grid = cg::this_grid();
  for (int ph = p.ph_lo; ph < p.ph_hi; ++ph) {
#ifndef ONLYPH
#define ONLYPH -1
#endif
#define PHON(k) (ONLYPH == -1 || ONLYPH == (k))
    if (ph == 0) { if constexpr (PHON(0)) phase0(p, lds); }
    else if (ph == 1) { if constexpr (PHON(1)) {
      pg8::Gemm g{(const bf16*)(p.ws + WS_XB), (const bf16*)(p.ws + WS_WINT), NTOK, LDY, DM, DM, DM};
      pg8::StaticOrder S; S.init(NTOK, LDY, gridDim.x, BID());
      pg8::EpiBf16<0> E{(bf16*)(p.ws + WS_Y1), LDY, nullptr, 0, 0};
      pg8::gemm_phase<pg8::EpiBf16<0>, pg8::StaticOrder, true, true>(lds, g, S, E);
    } } else if (ph == 2) { if constexpr (PHON(2)) phase_mixers(p, lds); }
    else if (ph == 3) { if constexpr (PHON(3)) phase_headnorm(p); }
    else if (ph == 4) { if constexpr (PHON(4)) {
      pg8::Gemm g{(const bf16*)(p.ws + WS_MIX), (const bf16*)(p.ws + WS_WBT), NTOK, DM, 2048, DM, DM};
      pg8::StaticOrder S; S.init(NTOK, DM, gridDim.x, BID());
      EpiGateM E{(float*)(p.ws + WS_T), (const bf16*)(p.ws + WS_Y1)};
      pg8::gemm_phase<EpiGateM, pg8::StaticOrder, true, true>(lds, g, S, E);
    } } else if (ph == 5) { if constexpr (PHON(5)) {
      pg8::Gemm g{(const bf16*)(p.ws + WS_MIX) + 2048, (const bf16*)(p.ws + WS_WBT) + 2048, NTOK, DM, 2048, DM, DM};
      pg8::StaticOrder S; S.init(NTOK, DM, gridDim.x, BID());
      EpiGateA E{(const float*)(p.ws + WS_T), (const bf16*)(p.ws + WS_Y1), (bf16*)(p.ws + WS_MRG)};
      pg8::gemm_phase<EpiGateA, pg8::StaticOrder, true, true>(lds, g, S, E);
    } } else if (ph == 6) { if constexpr (PHON(6)) {
      pg8::Gemm g{(const bf16*)(p.ws + WS_MRG), (const bf16*)(p.ws + WS_WOT), NTOK, DM, DM, DM, DM};
      pg8::StaticOrder S; S.init(NTOK, DM, gridDim.x, BID());
      EpiOut E{p.in[I_XP], p.in[I_XS], p.out};
      pg8::gemm_phase<EpiOut, pg8::StaticOrder, true, true>(lds, g, S, E);
    } } else { if constexpr (PHON(7)) phase_ln(p); }
    if (ph + 1 < p.ph_hi) grid.sync();
  }
}
#ifndef N_LAUNCH_PER_PHASE
#define N_LAUNCH_PER_PHASE 0
#endif
extern "C" void kernel_launch(void* const* d_in, const int* in_sizes, int n_in, void* d_out, int out_size, void* d_ws, size_t ws_size, hipStream_t stream) {
  constexpr int LDSB = 160 * 1024;
  static int grid = 0;
  if (!grid) {
    int dev = 0, cus = 0;
    if (n_in != 16 || ws_size < WS_END || out_size != 124527648) { fprintf(stderr, "kernel_launch: unexpected sizes n_in %d ws %zu (need %zu) out %d\n", n_in, ws_size, (size_t)WS_END, out_size); grid = -1; return; }
    (void)hipGetDevice(&dev);
    (void)hipDeviceGetAttribute(&cus, hipDeviceAttributeMultiprocessorCount, dev);
    (void)hipFuncSetAttribute((const void*)mega, hipFuncAttributeMaxDynamicSharedMemorySize, LDSB);
    grid = cus;
  }
  if (grid < 0) return;
  Params p{};
  for (int i = 0; i < 16; ++i) p.in[i] = (const float*)d_in[i];
  p.out = (float*)d_out; p.ws = (unsigned char*)d_ws;
#if N_LAUNCH_PER_PHASE
  for (int ph = 0; ph < NPHASES; ++ph) { p.ph_lo = ph; p.ph_hi = ph + 1; hipLaunchKernelGGL(mega, dim3(grid), dim3(512), LDSB, stream, p); }
#else
  p.ph_lo = 0; p.ph_hi = NPHASES;
  void* args[] = {&p};
  hipError_t e = hipLaunchCooperativeKernel((const void*)mega, dim3(grid), dim3(512), args, LDSB, stream);
  if (e != hipSuccess) fprintf(stderr, "cooperative launch failed: %s (grid %d)\n", hipGetErrorString(e), grid);
#endif
}
```

```cpp
#include <hip/hip_runtime.h>
#include <hip/hip_cooperative_groups.h>
#include <cstdio>
#include <cstdint>
namespace cg = cooperative_groups;
static __device__ __forceinline__ int TID() { int t = threadIdx.x; asm volatile("" : "+v"(t)); return t; }
static __device__ __forceinline__ int BID() { int t = blockIdx.x; asm volatile("" : "+s"(t)); return t; }
namespace pg8 {
#define PG8_LAS __attribute__((address_space(3)))
typedef unsigned short bf16_t;
typedef short bf16x8 __attribute__((ext_vector_type(8)));
typedef float f32x4 __attribute__((ext_vector_type(4)));
typedef unsigned u32x4 __attribute__((ext_vector_type(4)));
constexpr int BM = 256, BK = 64, HALF = 128, HTB = HALF * BK * 2  , STAGE_BYTES = 8 * HTB, NXCD = 8, WGM = 8;

__host__ __device__ __forceinline__ int lds_byte(int r, int c) { const int st = (r >> 4) * 2 + (c >> 5), rr = r & 15, cc = c & 31, ob = rr * 64 + cc * 2; return st * 1024 + (ob ^ (((ob >> 9) & 1) << 5)); }
__host__ __device__ __forceinline__ void stage_rc(int b, int& R, int& C) { const int st = b / 1024, sb = b % 1024, swz = sb ^ (((sb >> 9) & 1) << 5); R = (st >> 1) * 16 + swz / 64; C = (st & 1) * 32 + (swz % 64) / 2; }
__host__ __device__ __forceinline__ int perm32(int rho) { const int n = rho >> 4, i = rho & 15; return 8 * (i >> 2) + 4 * n + (i & 3); }

struct Unit { int pm, pn, k0, nk, kind; };
struct Gemm { const bf16_t* A; const bf16_t* Bt; int M, N, K, lda, ldb; };

struct StaticOrder {
    int nM, nN, nwg, G, c, nk;
    __host__ __device__ void init(int M, int N, int G_, int c_, int nk_) { nM = M / BM; nN = N / BM; nwg = nM * nN; G = G_; c = c_; nk = nk_; }
    __host__ __device__ bool next(int i, Unit& u) const {
        const long L = (long)i * G + c; if (L >= nwg) return false;
        int wgid = (int)L; { const int q = nwg / NXCD, r = nwg % NXCD, xcd = wgid % NXCD, off = wgid / NXCD; wgid = (xcd < r ? xcd * (q + 1) : r * (q + 1) + (xcd - r) * q) + off; }
        const int nig = WGM * nN, gid = wgid / nig, fm = gid * WGM, gsz = (nM - fm) < WGM ? (nM - fm) : WGM;
        u.pm = fm + ((wgid % nig) % gsz); u.pn = (wgid % nig) / gsz; u.k0 = 0; u.nk = nk; u.kind = 0; return true;
    }
    __device__ __forceinline__ void a_ready(const Unit&) const {}
    __device__ __forceinline__ void done(const Unit&) const {}
};

struct TailSplitOrder {
    int G, c, nk;
    __host__ __device__ void init(int G_, int c_, int nk_) { G = G_; c = c_; nk = nk_; }
    __host__ __device__ bool next(int i, Unit& u) const {
        const long L = (long)i * G + c; if (L >= 768) return false;
        const bool full = L < 512;
        const int ii = (int)L >> 8, cc = (int)L & 255, x = cc & 7, j = cc >> 3, w = ii * 32 + j;
        const int s = (int)L - 512, un = s >> 2, kq = s & 3;
        u.pm = full ? 4 * x + (w & 3) : 32 + (un >> 4); u.pn = full ? (w >> 2) : (un & 15); u.k0 = full ? 0 : kq * (nk >> 2); u.nk = full ? nk : (nk >> 2); u.kind = full ? 0 : 1;
        return true;
    }
    __device__ __forceinline__ void a_ready(const Unit&) const {}
    __device__ __forceinline__ void done(const Unit&) const {}
};

struct BandOrder {
    int G, c, nk;
    __host__ __device__ void init(int G_, int c_, int nk_) { G = G_; c = c_; nk = nk_; }
    __host__ __device__ bool next(int i, Unit& u) const {
        const long L = (long)i * G + c; const int x = (int)(L & 7), l = (int)(L >> 3);
        if (l >= 414) return false;
        u.pm = 9 * (x & 3) + (l % 9); u.pn = 46 * (x >> 2) + (l / 9); u.k0 = 0; u.nk = nk; u.kind = 0; return true;
    }
    __device__ __forceinline__ void a_ready(const Unit&) const {}
    __device__ __forceinline__ void done(const Unit&) const {}
};
__device__ __forceinline__ unsigned cvt_pk_bf16(float lo, float hi) { unsigned r; asm volatile("v_cvt_pk_bf16_f32 %0, %1, %2" : "=v"(r) : "v"(lo), "v"(hi)); return r; }
typedef float f32x2 __attribute__((ext_vector_type(2)));
template <int ACT> struct EpiBf16 {
    static constexpr bool PERM = true, AFTER_DRAIN = false, HAS_MID = false; static constexpr int MID_T = 0;
    bf16_t* O; int ldc; const float* bias; int split_cols; size_t split_stride;
    __device__ __forceinline__ void operator()(const f32x4 (&acc)[2][2][4][2], const Unit& u, int wr, int wc, int fr, int fq) const {
        const int row0 = u.pm * BM + wr * 64 + fr, col0 = u.pn * BM + wc * 32 + 8 * fq;
#pragma unroll
        for (int ai = 0; ai < 2; ++ai)
#pragma unroll
            for (int m = 0; m < 4; ++m) { bf16_t* rowp = O + (size_t)(row0 + ai * HALF + m * 16) * ldc + col0;
#pragma unroll
                for (int bj = 0; bj < 2; ++bj) { const f32x4 v0 = acc[ai][bj][m][0], v1 = acc[ai][bj][m][1];
                    u32x4 w; w.x = cvt_pk_bf16(v0[0], v0[1]); w.y = cvt_pk_bf16(v0[2], v0[3]); w.z = cvt_pk_bf16(v1[0], v1[1]); w.w = cvt_pk_bf16(v1[2], v1[3]);
                    *(u32x4*)(rowp + bj * HALF) = w; } }
    }
};
template <class Epi, class Sched, bool ALIGN_EPI = false, bool SP2 = false>
__device__ __forceinline__ void gemm_phase(PG8_LAS unsigned char* lds, const Gemm g, const Sched& S, const Epi& E) {
    const int tid = TID(), wid = __builtin_amdgcn_readfirstlane(tid >> 6), lane = tid & 63, wr = wid >> 2, wc = wid & 3, fr = lane & 15, fq = lane >> 4;
    unsigned voffA[2], voffB[2];
#pragma unroll
    for (int i = 0; i < 2; ++i) { int R, C; stage_rc(tid * 16 + i * 8192, R, C); const int Rb = Epi::PERM ? ((R & ~31) + perm32(R & 31)) : R;
        voffA[i] = (unsigned)(R * g.lda + C) * 2u; voffB[i] = (unsigned)(Rb * g.ldb + C) * 2u; }
    const size_t kstep = (size_t)(BK * 2);
    const size_t hstepA = (size_t)HALF * g.lda * 2, hstepB = (size_t)HALF * g.ldb * 2;
    const size_t tstepA = 2 * hstepA, tstepB = 2 * hstepB;
    const unsigned ldsw = (unsigned)wid * 1024u;
    const int aoff = lds_byte(wr * 64 + fr, fq * 8), boff = lds_byte(wc * 32 + fr, fq * 8);
#define PG8_SA(b, h) (((b) * 2 + (h)) * HTB)
#define PG8_SB(b, h) ((4 + (b) * 2 + (h)) * HTB)
#define PG8_STAGE(bufoff, gbase, voff) do { _Pragma("unroll") for (int _i = 0; _i < 2; ++_i) \
        __builtin_amdgcn_global_load_lds((const unsigned*)((const char*)(gbase) + (voff)[_i]), (PG8_LAS unsigned*)(lds + (bufoff) + ldsw + _i * 8192), 16, 0, 0); } while (0)
#define PG8_LDA(dst, b, h) do { _Pragma("unroll") for (int m = 0; m < 4; ++m) _Pragma("unroll") for (int k = 0; k < 2; ++k) dst[m][k] = *(const PG8_LAS bf16x8*)(lds + PG8_SA(b, h) + aoff + m * 2048 + k * 1024); } while (0)
#define PG8_LDB(dst, b, h) do { _Pragma("unroll") for (int n = 0; n < 2; ++n) _Pragma("unroll") for (int k = 0; k < 2; ++k) dst[n][k] = *(const PG8_LAS bf16x8*)(lds + PG8_SB(b, h) + boff + n * 2048 + k * 1024); } while (0)
#define PG8_MMA(ai, bj, At, Bt) do { __builtin_amdgcn_s_setprio(1); _Pragma("unroll") for (int m = 0; m < 4; ++m) _Pragma("unroll") for (int n = 0; n < 2; ++n) _Pragma("unroll") for (int k = 0; k < 2; ++k) \
        acc[ai][bj][m][n] = __builtin_amdgcn_mfma_f32_16x16x32_bf16(Bt[n][k], At[m][k], acc[ai][bj][m][n], 0, 0, 0); __builtin_amdgcn_s_setprio(0); } while (0)
#define PG8_WAIT_V(n) asm volatile("s_waitcnt vmcnt(" #n ")" ::: "memory")
#define PG8_WAIT_L(n) asm volatile("s_waitcnt lgkmcnt(" #n ")" ::: "memory")
#define PG8_BAR __builtin_amdgcn_s_barrier()
#define PG8_SCHED __builtin_amdgcn_sched_barrier(0)
    Unit cur, nxt; int ui = 0;
    if (!S.next(0, cur)) return;
    f32x4 acc[2][2][4][2];
#pragma unroll
    for (int a = 0; a < 2; ++a)
#pragma unroll
        for (int b = 0; b < 2; ++b)
#pragma unroll
            for (int m = 0; m < 4; ++m)
#pragma unroll
                for (int n = 0; n < 2; ++n) acc[a][b][m][n] = (f32x4){0.f, 0.f, 0.f, 0.f};
    bf16x8 At[4][2], B0[2][2], B1[2][2];
    const char* cA = (const char*)g.A + (size_t)cur.pm * tstepA + (size_t)cur.k0 * kstep; const char* cB = (const char*)g.Bt + (size_t)cur.pn * tstepB + (size_t)cur.k0 * kstep;
    S.a_ready(cur);
    if constexpr (SP2) {
        PG8_STAGE(PG8_SB(0, 0), cB, voffB); PG8_STAGE(PG8_SB(0, 1), cB + hstepB, voffB); PG8_STAGE(PG8_SA(0, 0), cA, voffA); PG8_STAGE(PG8_SA(0, 1), cA + hstepA, voffA);
        if (wr == 1) PG8_BAR;
        PG8_WAIT_V(2); PG8_BAR;
        PG8_STAGE(PG8_SB(1, 0), cB + kstep, voffB); PG8_STAGE(PG8_SA(1, 0), cA + kstep, voffA); PG8_STAGE(PG8_SB(1, 1), cB + hstepB + kstep, voffB);
        PG8_WAIT_V(6); PG8_BAR;
    } else {
        PG8_STAGE(PG8_SB(0, 0), cB, voffB); PG8_STAGE(PG8_SA(0, 0), cA, voffA); PG8_STAGE(PG8_SB(0, 1), cB + hstepB, voffB); PG8_STAGE(PG8_SA(0, 1), cA + hstepA, voffA);
        if (wr == 1) PG8_BAR;
        PG8_WAIT_V(4); PG8_BAR;
        PG8_STAGE(PG8_SB(1, 0), cB + kstep, voffB); PG8_STAGE(PG8_SA(1, 0), cA + kstep, voffA); PG8_STAGE(PG8_SB(1, 1), cB + hstepB + kstep, voffB);
        PG8_WAIT_V(6); PG8_BAR;
    }
    for (;;) {
        const bool has_next = S.next(ui + 1, nxt);
        const char* nA = has_next ? (const char*)g.A + (size_t)nxt.pm * tstepA + (size_t)nxt.k0 * kstep : cA; const char* nB = has_next ? (const char*)g.Bt + (size_t)nxt.pn * tstepB + (size_t)nxt.k0 * kstep : cB;
        const int nt = cur.nk;
        for (int t = 0; t < nt; t += 2) {
            const bool last = (t == nt - 2);
            if constexpr (Epi::HAS_MID) { if (t == Epi::MID_T && cur.kind == 0) E.mid(acc, cur, wr, wc, fr, fq); }
            const char* a1 = cA + (size_t)(t + 1) * kstep;
            const char* a2 = last ? nA : cA + (size_t)(t + 2) * kstep; const char* b2 = last ? nB : cB + (size_t)(t + 2) * kstep;
            const char* a3 = a2 + kstep; const char* b3 = b2 + kstep;
            if (last && has_next) S.a_ready(nxt);
            if constexpr (SP2) {
            PG8_LDB(B0, 0, 0); PG8_LDB(B1, 0, 1); PG8_SCHED; PG8_LDA(At, 0, 0); PG8_STAGE(PG8_SA(1, 1), a1 + hstepA, voffA);
            PG8_WAIT_V(8); PG8_WAIT_L(0); PG8_BAR; PG8_MMA(0, 0, At, B0); PG8_MMA(0, 1, At, B1); PG8_BAR; PG8_SCHED;
            PG8_LDA(At, 0, 1); PG8_STAGE(PG8_SB(0, 0), b2, voffB); PG8_STAGE(PG8_SB(0, 1), b2 + hstepB, voffB); PG8_STAGE(PG8_SA(0, 0), a2, voffA);
            PG8_WAIT_V(8); PG8_WAIT_L(0); PG8_BAR; PG8_MMA(1, 0, At, B0); PG8_MMA(1, 1, At, B1); PG8_BAR; PG8_SCHED;
            PG8_LDB(B0, 1, 0); PG8_LDB(B1, 1, 1); PG8_SCHED; PG8_LDA(At, 1, 0); PG8_STAGE(PG8_SA(0, 1), a2 + hstepA, voffA);
            PG8_WAIT_V(8); PG8_WAIT_L(0); PG8_BAR; PG8_MMA(0, 0, At, B0); PG8_MMA(0, 1, At, B1); PG8_BAR; PG8_SCHED;
            PG8_LDA(At, 1, 1); PG8_STAGE(PG8_SB(1, 0), b3, voffB); PG8_STAGE(PG8_SB(1, 1), b3 + hstepB, voffB); PG8_STAGE(PG8_SA(1, 0), a3, voffA);
            PG8_WAIT_V(8); PG8_WAIT_L(0); PG8_BAR; PG8_MMA(1, 0, At, B0); PG8_MMA(1, 1, At, B1); PG8_BAR; PG8_SCHED;
            } else {
            PG8_LDB(B0, 0, 0); PG8_SCHED; PG8_LDA(At, 0, 0); PG8_STAGE(PG8_SA(1, 1), a1 + hstepA, voffA);
            PG8_WAIT_L(8); PG8_BAR; PG8_WAIT_L(0); PG8_MMA(0, 0, At, B0); PG8_BAR; PG8_SCHED;
            PG8_LDB(B1, 0, 1); PG8_STAGE(PG8_SB(0, 0), b2, voffB);
            PG8_BAR; PG8_WAIT_L(0); PG8_MMA(0, 1, At, B1); PG8_BAR;
            PG8_LDA(At, 0, 1); PG8_STAGE(PG8_SA(0, 0), a2, voffA);
            PG8_BAR; PG8_WAIT_L(0); PG8_MMA(1, 0, At, B0); PG8_BAR; PG8_SCHED;
            PG8_STAGE(PG8_SB(0, 1), b2 + hstepB, voffB);
            PG8_WAIT_V(6); PG8_BAR; PG8_MMA(1, 1, At, B1); PG8_BAR;
            PG8_LDB(B0, 1, 0); PG8_SCHED; PG8_LDA(At, 1, 0); PG8_STAGE(PG8_SA(0, 1), a2 + hstepA, voffA);
            PG8_WAIT_L(8); PG8_BAR; PG8_WAIT_L(0); PG8_MMA(0, 0, At, B0); PG8_BAR; PG8_SCHED;
            PG8_LDB(B1, 1, 1); PG8_STAGE(PG8_SB(1, 0), b3, voffB);
            PG8_BAR; PG8_WAIT_L(0); PG8_MMA(0, 1, At, B1); PG8_BAR;
            PG8_LDA(At, 1, 1); PG8_STAGE(PG8_SA(1, 0), a3, voffA);
            PG8_BAR; PG8_WAIT_L(0); PG8_MMA(1, 0, At, B0); PG8_BAR; PG8_SCHED;
            PG8_STAGE(PG8_SB(1, 1), b3 + hstepB, voffB);
            PG8_WAIT_V(6); PG8_BAR; PG8_MMA(1, 1, At, B1); PG8_BAR;
            }
        }
        if constexpr (ALIGN_EPI) { if (wr == 0) PG8_BAR; }
        if constexpr (!Epi::AFTER_DRAIN) { E(acc, cur, wr, wc, fr, fq); S.done(cur); }
        if (!has_next) break;
#pragma unroll
        for (int a = 0; a < 2; ++a)
#pragma unroll
            for (int b = 0; b < 2; ++b)
#pragma unroll
                for (int m = 0; m < 4; ++m)
#pragma unroll
                    for (int n = 0; n < 2; ++n) acc[a][b][m][n] = (f32x4){0.f, 0.f, 0.f, 0.f};
        cur = nxt; cA = nA; cB = nB; ++ui;
        if constexpr (ALIGN_EPI) { if (wr == 1) PG8_BAR; }
    }
    PG8_WAIT_V(0);
    if constexpr (!ALIGN_EPI) { if (wr == 0) PG8_BAR; }
    PG8_BAR;
    if constexpr (Epi::AFTER_DRAIN) { E.fused(acc, cur, wr, wc, fr, fq, lds, wid, lane); S.done(cur); }
#undef PG8_SA
#undef PG8_SB
#undef PG8_STAGE
#undef PG8_LDA
#undef PG8_LDB
#undef PG8_MMA
#undef PG8_WAIT_V
#undef PG8_WAIT_L
#undef PG8_BAR
#undef PG8_SCHED
}
}
#define LAS __attribute__((address_space(3)))
#define DI __device__ __forceinline__
typedef unsigned short bf16;
typedef short bf16x8 __attribute__((ext_vector_type(8)));
typedef float f32x4 __attribute__((ext_vector_type(4)));
typedef float f32x2 __attribute__((ext_vector_type(2)));
typedef unsigned u32x4 __attribute__((ext_vector_type(4)));
typedef unsigned u32x2 __attribute__((ext_vector_type(2)));

constexpr int DM = 4096, NTOK = 9216, NPR = 8192, SEQ = 2048;
constexpr int LDY = 23552;
constexpr int C_QM = 0, C_KM = 2048, C_VM = 4096, C_OM = 6144, C_ZM = 8192, C_QA = 10240, C_KA = 12288, C_VA = 12800, C_ZA = 13312, C_GM = 15360, C_GA = 19456;
constexpr int LDW = 23568;
constexpr int NROPE = 2056;
constexpr size_t O_YP = 0, O_YS = 33554432, O_PC = 37748736, O_PN = 39845888, O_PM = 39854080, O_PK = 39854112, O_PV = 40116256,
                 O_SC = 40378400, O_SN = 107487264, O_SM = 107749408, O_SK = 107750432, O_SV = 116139040;
constexpr size_t WS_XB = 0;
constexpr size_t WS_WINT = WS_XB + (size_t)NTOK * DM * 2;
constexpr size_t WS_WBT = WS_WINT + (size_t)LDY * DM * 2;
constexpr size_t WS_WOT = WS_WBT + (size_t)DM * DM * 2;
constexpr size_t WS_Y1 = WS_WOT + (size_t)DM * DM * 2;
constexpr size_t WS_G4 = WS_Y1 + (size_t)NTOK * LDY * 2;
constexpr size_t WS_ROPE = WS_G4 + (size_t)4 * NTOK * 16 * 4;
constexpr size_t WS_HB = WS_ROPE + (size_t)NROPE * 64 * 4;
constexpr size_t WS_MIX = WS_HB + (size_t)NTOK * 2048 * 2;
constexpr size_t WS_T = WS_MIX + (size_t)NTOK * DM * 2;
constexpr size_t WS_P2 = WS_T, WS_P3 = WS_T + (size_t)4 * 1024 * DM * 4;
constexpr size_t WS_MRG = WS_T + (size_t)NTOK * DM * 4;
constexpr size_t WS_Z = WS_MRG + (size_t)NTOK * DM * 2;
constexpr size_t WS_BAR = WS_Z + (size_t)NTOK * DM * 2;
constexpr size_t WS_END = WS_BAR + 16384;

struct Params { const float* in[16]; float* out; unsigned char* ws; int ph_lo, ph_hi; };
enum { I_XP = 0, I_XS, I_SC, I_SN, I_SM, I_CK, I_CV, I_WIN, I_BIF, I_NMG, I_SINK, I_WBM, I_WBA, I_WOUT, I_LNG, I_LNB };

DI float bf2f(unsigned b) { return __uint_as_float(b << 16); }
DI float bflo(unsigned w) { return __uint_as_float(w << 16); }
DI float bfhi(unsigned w) { return __uint_as_float(w & 0xffff0000u); }
DI unsigned pk2(float lo, float hi) { return pg8::cvt_pk_bf16(lo, hi); }
DI bf16 f2bf(float f) { return (bf16)(pk2(f, 0.f) & 0xffffu); }
DI float rcpf_(float x) { return __builtin_amdgcn_rcpf(x); }
DI float sigm(float x) { return __builtin_amdgcn_rcpf(1.f + __expf(-x)); }
DI float wave_sum(float v) {
#pragma unroll
  for (int o = 1; o < 64; o <<= 1) v += __shfl_xor(v, o);
  return v;
}
#define LDS_FENCE() asm volatile("s_waitcnt lgkmcnt(0)" ::: "memory")
#define MFMA16(a, b, c) __builtin_amdgcn_mfma_f32_16x16x32_bf16((a), (b), (c), 0, 0, 0)

DI void tr_item(const float* __restrict__ W, int ldw, int k0, int n0, bf16* __restrict__ WT, int ldt, int trow0, int tcol0, LAS unsigned* scr, int lane) {
  const int l16 = lane & 15, kq = lane >> 4;
  f32x4 v[16];
#pragma unroll
  for (int i = 0; i < 8; ++i) {
    const int k = 8 * i + 2 * kq;
    v[2 * i] = *(const f32x4*)(W + (size_t)(k0 + k) * ldw + n0 + l16 * 4);
    v[2 * i + 1] = *(const f32x4*)(W + (size_t)(k0 + k + 1) * ldw + n0 + l16 * 4);
  }
#pragma unroll
  for (int i = 0; i < 8; ++i) {
    const int kp = 4 * i + kq;
#pragma unroll
    for (int j = 0; j < 4; ++j) scr[(l16 * 4 + j) * 33 + kp] = pk2(v[2 * i][j], v[2 * i + 1][j]);
  }
  LDS_FENCE();
#pragma unroll
  for (int u = 0; u < 8; ++u) {
    const int n = u * 8 + (lane >> 3), kc = lane & 7;
    u32x4 o; o.x = scr[n * 33 + kc * 4]; o.y = scr[n * 33 + kc * 4 + 1]; o.z = scr[n * 33 + kc * 4 + 2]; o.w = scr[n * 33 + kc * 4 + 3];
    *(u32x4*)(WT + (size_t)(trow0 + n) * ldt + tcol0 + kc * 8) = o;
  }
  LDS_FENCE();
}
DI void xcvt_item(const Params& p, int item, int lane) {
  const int rg = item >> 2, kq4 = item & 3, r = lane & 15, q = lane >> 4;
  const int row = rg * 16 + r;
  const float* xr = row < NPR ? p.in[I_XP] + (size_t)row * DM : p.in[I_XS] + (size_t)(row - NPR) * DM;
  const float* wif = p.in[I_WIN] + 10240 + r;
  bf16* xb = (bf16*)(p.ws + WS_XB) + (size_t)row * DM;
  f32x4 acc = {0.f, 0.f, 0.f, 0.f};
#pragma unroll 2
  for (int k0 = kq4 * 1024; k0 < kq4 * 1024 + 1024; k0 += 64) {
    f32x4 xv[4]; float wv[4][4];
#pragma unroll
    for (int u = 0; u < 4; ++u) xv[u] = *(const f32x4*)(xr + k0 + 16 * u + 4 * q);
#pragma unroll
    for (int u = 0; u < 4; ++u)
#pragma unroll
      for (int i = 0; i < 4; ++i) wv[u][i] = wif[(size_t)(k0 + 16 * u + 4 * q + i) * LDW];
#pragma unroll
    for (int u = 0; u < 4; ++u) {
#pragma unroll
      for (int i = 0; i < 4; ++i) acc = __builtin_amdgcn_mfma_f32_16x16x4f32(xv[u][i], wv[u][i], acc, 0, 0, 0);
      u32x2 o; o.x = pk2(xv[u][0], xv[u][1]); o.y = pk2(xv[u][2], xv[u][3]);
      *(u32x2*)(xb + k0 + 16 * u + 4 * q) = o;
    }
  }
  float* g4 = (float*)(p.ws + WS_G4) + (size_t)kq4 * NTOK * 16;
#pragma unroll
  for (int j = 0; j < 4; ++j) g4[(size_t)(rg * 16 + 4 * q + j) * 16 + r] = acc[j];
}
DI void phase0(const Params& p, LAS unsigned char* lds) {
  const int tid = TID(), lane = tid & 63, wave = tid >> 6;
  const int gw = BID() * 8 + wave, NGW = gridDim.x * 8;
  LAS unsigned* scr = (LAS unsigned*)(lds + wave * 8704);
  {
    float* rt = (float*)(p.ws + WS_ROPE);
    for (int i = BID() * 512 + tid; i < NROPE * 32; i += gridDim.x * 512) {
      const int pi = i >> 5, fi = i & 31;
      const int pos = pi < SEQ ? pi : 8192 + (pi - SEQ);
      double inv = 1.0; const double rr = 0.74989420933245582730;
      for (int j = 0; j < fi; ++j) inv *= rr;
      double rev = (double)pos * inv * 0.15915494309189533577;
      rev -= floor(rev);
      const float rf = (float)rev;
      rt[pi * 64 + fi] = __builtin_amdgcn_cosf(rf);
      rt[pi * 64 + 32 + fi] = __builtin_amdgcn_sinf(rf);
    }
  }
  constexpr int N_X = (NTOK / 16) * 4;
  constexpr int N_WIN = 64 * (LDY / 64);
  constexpr int N_WB = 32 * 64, N_WO = 64 * 64;
  constexpr int NITEMS = N_X + N_WIN + 2 * N_WB + N_WO;
  for (int it = gw; it < NITEMS; it += NGW) {
    int r = it;
    if (r < N_X) { xcvt_item(p, r, lane); continue; } r -= N_X;
    if (r < N_WIN) { const int kt = r % 64, nt = r / 64; const int n0 = nt * 64;
      tr_item(p.in[I_WIN], LDW, kt * 64, n0 < 10240 ? n0 : n0 + 16, (bf16*)(p.ws + WS_WINT), DM, n0, kt * 64, scr, lane); continue; } r -= N_WIN;
    if (r < N_WB) { const int kt = r % 32, nt = r / 32; tr_item(p.in[I_WBM], DM, kt * 64, nt * 64, (bf16*)(p.ws + WS_WBT), DM, nt * 64, kt * 64, scr, lane); continue; } r -= N_WB;
    if (r < N_WB) { const int kt = r % 32, nt = r / 32; tr_item(p.in[I_WBA], DM, kt * 64, nt * 64, (bf16*)(p.ws + WS_WBT), DM, nt * 64, 2048 + kt * 64, scr, lane); continue; } r -= N_WB;
    { const int kt = r % 64, nt = r / 64; tr_item(p.in[I_WOUT], DM, kt * 64, nt * 64, (bf16*)(p.ws + WS_WOT), DM, nt * 64, kt * 64, scr, lane); }
  }
}
constexpr int MP_Q = 0, MP_K = 33792, MP_KT = 67584, MP_CT = 104448, MP_VT = 129792, MP_WVT = 136704, MP_S = 143616, MP_F = 152832;
DI void mlstm_prompt_item(const Params& p, LAS unsigned char* lds, int item) {
  const int tid = TID(), lane = tid & 63, w = __builtin_amdgcn_readfirstlane(tid >> 6), r = lane & 15, q = lane >> 4;
  const int sl = item & 7, h = (item >> 3) & 7, b = item >> 6;
  const bf16* Y1 = (const bf16*)(p.ws + WS_Y1);
  const float* G4 = (const float*)(p.ws + WS_G4);
  bf16* HB = (bf16*)(p.ws + WS_HB);
  LAS float* Fb = (LAS float*)(lds + MP_F);
  const float bi = p.in[I_BIF][h], bfg = p.in[I_BIF][8 + h];
  for (int i = tid; i < 48 * 264 / 2; i += 512) ((LAS unsigned*)(lds + MP_CT))[i] = 0u;
  for (int i = tid; i < 48 * 72 / 2; i += 512) { const int row = i / 36; ((LAS unsigned*)(lds + MP_VT))[i] = row == 32 ? 0x3f803f80u : 0u; ((LAS unsigned*)(lds + MP_WVT))[i] = 0u; }
  f32x4 st[2][3];
#pragma unroll
  for (int a = 0; a < 2; ++a)
#pragma unroll
    for (int e = 0; e < 3; ++e) st[a][e] = (f32x4){0.f, 0.f, 0.f, 0.f};
  float m_prev = 0.f;
  u32x4 pq[4], pk[4]; unsigned pkt[16]; unsigned pv[4]; float pgr[8] = {0.f, 0.f, 0.f, 0.f, 0.f, 0.f, 0.f, 0.f};
  const int dp = tid & 127, sg = tid >> 7;
  const int ve = tid & 31, vs = tid >> 5;
  auto issue = [&](int c) {
    const size_t row0 = (size_t)b * SEQ + (size_t)c * 64;
#pragma unroll
    for (int i = 0; i < 4; ++i) { const int id = tid + 512 * i, row = id >> 5, cc = id & 31;
      pq[i] = *(const u32x4*)(Y1 + (row0 + row) * LDY + C_QM + h * 256 + cc * 8);
      pk[i] = *(const u32x4*)(Y1 + (row0 + row) * LDY + C_KM + h * 256 + cc * 8); }
#pragma unroll
    for (int i = 0; i < 16; ++i) pkt[i] = *(const unsigned*)(Y1 + (row0 + sg * 16 + i) * LDY + C_KM + h * 256 + 2 * dp);
#pragma unroll
    for (int i = 0; i < 4; ++i) pv[i] = (unsigned)Y1[(row0 + vs * 4 + i) * LDY + C_VM + h * 256 + sl * 32 + ve];
    if (w == 7) {
#pragma unroll
      for (int k4 = 0; k4 < 4; ++k4) { pgr[k4] = G4[((size_t)k4 * NTOK + row0 + lane) * 16 + h]; pgr[4 + k4] = G4[((size_t)k4 * NTOK + row0 + lane) * 16 + 8 + h]; } }
  };
  auto commit = [&]() {
#pragma unroll
    for (int i = 0; i < 4; ++i) { const int id = tid + 512 * i, row = id >> 5, cc = id & 31;
      *(LAS u32x4*)(lds + MP_Q + row * 528 + cc * 16) = pq[i]; *(LAS u32x4*)(lds + MP_K + row * 528 + cc * 16) = pk[i]; }
    { u32x4 a0, a1, b0, b1;
      a0.x = (pkt[0] & 0xffffu) | (pkt[1] << 16); a0.y = (pkt[2] & 0xffffu) | (pkt[3] << 16); a0.z = (pkt[4] & 0xffffu) | (pkt[5] << 16); a0.w = (pkt[6] & 0xffffu) | (pkt[7] << 16);
      a1.x = (pkt[8] & 0xffffu) | (pkt[9] << 16); a1.y = (pkt[10] & 0xffffu) | (pkt[11] << 16); a1.z = (pkt[12] & 0xffffu) | (pkt[13] << 16); a1.w = (pkt[14] & 0xffffu) | (pkt[15] << 16);
      b0.x = (pkt[0] >> 16) | (pkt[1] & 0xffff0000u); b0.y = (pkt[2] >> 16) | (pkt[3] & 0xffff0000u); b0.z = (pkt[4] >> 16) | (pkt[5] & 0xffff0000u); b0.w = (pkt[6] >> 16) | (pkt[7] & 0xffff0000u);
      b1.x = (pkt[8] >> 16) | (pkt[9] & 0xffff0000u); b1.y = (pkt[10] >> 16) | (pkt[11] & 0xffff0000u); b1.z = (pkt[12] >> 16) | (pkt[13] & 0xffff0000u); b1.w = (pkt[14] >> 16) | (pkt[15] & 0xffff0000u);
      LAS unsigned char* kt0 = lds + MP_KT + (2 * dp) * 144 + sg * 32;
      *(LAS u32x4*)(kt0) = a0; *(LAS u32x4*)(kt0 + 16) = a1; *(LAS u32x4*)(kt0 + 144) = b0; *(LAS u32x4*)(kt0 + 160) = b1; }
    asm volatile("" : "+v"(pv[0]), "+v"(pv[1]), "+v"(pv[2]), "+v"(pv[3]));
    { u32x2 o; o.x = pv[0] | (pv[1] << 16); o.y = pv[2] | (pv[3] << 16);
      *(LAS u32x2*)(lds + MP_VT + ve * 144 + vs * 8) = o; }
  };
  float gi = 0.f, gf = 0.f;
  auto scan = [&](LAS float* F) {
    const float igv = gi + bi; const float xf = gf + bfg;
    const float lfv = fminf(xf, 0.f) - log1pf(__expf(-fabsf(xf)));
    float bc = lfv;
#pragma unroll
    for (int o = 1; o < 64; o <<= 1) { const float t = __shfl_up(bc, o); if (lane >= o) bc += t; }
    float pm = igv - bc;
#pragma unroll
    for (int o = 1; o < 64; o <<= 1) { const float t = __shfl_up(pm, o); if (lane >= o) pm = fmaxf(pm, t); }
    const float a = bc + m_prev, mt = fmaxf(a, bc + pm);
    const float m_new = __shfl(mt, 63), bl = __shfl(bc, 63);
    F[lane] = __expf(bc - mt); F[64 + lane] = __expf(igv - bc) * 0.0625f; F[128 + lane] = mt;     F[192 + lane] = __expf(a - mt); F[256 + lane] = __expf(bl - bc + igv - m_new) * 0.0625f;
    if (lane == 0) F[384] = __expf(bl + m_prev - m_new);
    m_prev = m_new;
  };
  issue(0);
  __syncthreads();
  commit();
  asm volatile("" : "+v"(pgr[0]), "+v"(pgr[1]), "+v"(pgr[2]), "+v"(pgr[3]), "+v"(pgr[4]), "+v"(pgr[5]), "+v"(pgr[6]), "+v"(pgr[7]));
  gi = (pgr[0] + pgr[1]) + (pgr[2] + pgr[3]); gf = (pgr[4] + pgr[5]) + (pgr[6] + pgr[7]);
  if (w == 7) scan(Fb);
  const int tt = w >> 1, stb = (w & 1) * 2;
  for (int c = 0; c < 32; ++c) {
    const size_t row0 = (size_t)b * SEQ + (size_t)c * 64;
    LAS float* F = Fb + (c & 1) * 400; LAS float* Fn = Fb + ((c + 1) & 1) * 400;
    if (c + 1 < 32) issue(c + 1);
    __syncthreads();
    bf16 og[2][4];
    if (w < 4) {
#pragma unroll
      for (int et = 0; et < 2; ++et)
#pragma unroll
        for (int j = 0; j < 4; ++j) og[et][j] = Y1[(row0 + w * 16 + 4 * q + j) * LDY + C_OM + h * 256 + sl * 32 + et * 16 + r];
    }
    f32x4 sa[2] = {(f32x4){0.f, 0.f, 0.f, 0.f}, (f32x4){0.f, 0.f, 0.f, 0.f}};
#pragma unroll
    for (int ks = 0; ks < 8; ++ks) {
      const bf16x8 af = *(const LAS bf16x8*)(lds + MP_Q + (tt * 16 + r) * 528 + ks * 64 + q * 16);
#pragma unroll
      for (int j = 0; j < 2; ++j) if (stb + j <= tt) {
        const bf16x8 bfr = *(const LAS bf16x8*)(lds + MP_K + ((stb + j) * 16 + r) * 528 + ks * 64 + q * 16);
        sa[j] = MFMA16(af, bfr, sa[j]); }
    }
#pragma unroll
    for (int j = 0; j < 2; ++j) {
      const int s = (stb + j) * 16 + r; const float cf = F[64 + s];
#pragma unroll
      for (int g = 0; g < 4; ++g) { const int t = tt * 16 + 4 * q + g;
        const float v = (s <= t) ? sa[j][g] * (F[t] * cf) : 0.f;
        *(LAS bf16*)(lds + MP_S + t * 144 + s * 2) = f2bf(v); }
    }
    {
      const u32x2 vv = *(const LAS u32x2*)(lds + MP_VT + ve * 144 + vs * 8);
      const float w0 = F[256 + vs * 4], w1 = F[256 + vs * 4 + 1], w2 = F[256 + vs * 4 + 2], w3 = F[256 + vs * 4 + 3];
      u32x2 o; o.x = pk2(bflo(vv.x) * w0, bfhi(vv.x) * w1); o.y = pk2(bflo(vv.y) * w2, bfhi(vv.y) * w3);
      *(LAS u32x2*)(lds + MP_WVT + ve * 144 + vs * 8) = o;
      if (tid < 64) *(LAS bf16*)(lds + MP_WVT + 32 * 144 + tid * 2) = f2bf(F[256 + tid]);
    }
    __syncthreads();
    f32x4 nS[2] = {(f32x4){0.f, 0.f, 0.f, 0.f}, (f32x4){0.f, 0.f, 0.f, 0.f}}, nC[2] = {(f32x4){0.f, 0.f, 0.f, 0.f}, (f32x4){0.f, 0.f, 0.f, 0.f}};
    const int t4 = w & 3, e0 = (w < 4) ? 0 : 2, ne = (w < 4) ? 2 : 1;
#pragma unroll
    for (int ks = 0; ks < 2; ++ks) {
      const bf16x8 af = *(const LAS bf16x8*)(lds + MP_S + (t4 * 16 + r) * 144 + ks * 64 + q * 16);
#pragma unroll
      for (int j = 0; j < 2; ++j) if (j < ne) { const bf16x8 bfr = *(const LAS bf16x8*)(lds + MP_VT + ((e0 + j) * 16 + r) * 144 + ks * 64 + q * 16); nS[j] = MFMA16(af, bfr, nS[j]); }
    }
#pragma unroll
    for (int ks = 0; ks < 8; ++ks) {
      const bf16x8 af = *(const LAS bf16x8*)(lds + MP_Q + (t4 * 16 + r) * 528 + ks * 64 + q * 16);
#pragma unroll
      for (int j = 0; j < 2; ++j) if (j < ne) { const bf16x8 bfr = *(const LAS bf16x8*)(lds + MP_CT + ((e0 + j) * 16 + r) * 528 + ks * 64 + q * 16); nC[j] = MFMA16(af, bfr, nC[j]); }
    }
    float num[2][4];
#pragma unroll
    for (int j = 0; j < 2; ++j)
#pragma unroll
      for (int g = 0; g < 4; ++g) num[j][g] = nS[j][g] + F[192 + t4 * 16 + 4 * q + g] * nC[j][g];
    if (w >= 4 && r == 0) {
#pragma unroll
      for (int g = 0; g < 4; ++g) F[320 + t4 * 16 + 4 * q + g] = num[0][g];
    }
    { const float dec = F[384];
#pragma unroll
      for (int a = 0; a < 2; ++a)
#pragma unroll
        for (int e = 0; e < 3; ++e) st[a][e] *= dec;
#pragma unroll
      for (int ks = 0; ks < 2; ++ks) {
        bf16x8 bw[3];
#pragma unroll
        for (int e = 0; e < 3; ++e) bw[e] = *(const LAS bf16x8*)(lds + MP_WVT + (e * 16 + r) * 144 + ks * 64 + q * 16);
#pragma unroll
        for (int a = 0; a < 2; ++a) { const bf16x8 af = *(const LAS bf16x8*)(lds + MP_KT + ((2 * w + a) * 16 + r) * 144 + ks * 64 + q * 16);
#pragma unroll
          for (int e = 0; e < 3; ++e) st[a][e] = MFMA16(af, bw[e], st[a][e]); }
      }
    }
    __syncthreads();
    if (w < 4) {
#pragma unroll
      for (int g = 0; g < 4; ++g) { const int t = t4 * 16 + 4 * q + g; const float dn = fmaxf(fabsf(F[320 + t]), __expf(-F[128 + t])), rd = rcpf_(dn);
#pragma unroll
        for (int j = 0; j < 2; ++j) HB[(row0 + t) * 2048 + h * 256 + sl * 32 + j * 16 + r] = f2bf(sigm(bf2f(og[j][g])) * num[j][g] * rd); }
    }
#pragma unroll
    for (int a = 0; a < 2; ++a)
#pragma unroll
      for (int e = 0; e < 3; ++e) { u32x2 o; o.x = pk2(st[a][e][0], st[a][e][1]); o.y = pk2(st[a][e][2], st[a][e][3]);
        *(LAS u32x2*)(lds + MP_CT + (e * 16 + r) * 528 + ((2 * w + a) * 16 + 4 * q) * 2) = o; }
    if (c + 1 < 32) { commit(); asm volatile("" : "+v"(pgr[0]), "+v"(pgr[1]), "+v"(pgr[2]), "+v"(pgr[3]), "+v"(pgr[4]), "+v"(pgr[5]), "+v"(pgr[6]), "+v"(pgr[7])); gi = (pgr[0] + pgr[1]) + (pgr[2] + pgr[3]); gf = (pgr[4] + pgr[5]) + (pgr[6] + pgr[7]); if (w == 7) scan(Fn); }
  }
  float* oC = p.out + O_PC + (size_t)(b * 8 + h) * 65536;
#pragma unroll
  for (int a = 0; a < 2; ++a)
#pragma unroll
    for (int g = 0; g < 4; ++g) { const int d = (2 * w + a) * 16 + 4 * q + g;
      oC[(size_t)d * 256 + sl * 32 + r] = st[a][0][g]; oC[(size_t)d * 256 + sl * 32 + 16 + r] = st[a][1][g];
      if (sl == 0 && r == 0) p.out[O_PN + (size_t)(b * 8 + h) * 256 + d] = st[a][2][g]; }
  if (sl == 0 && tid == 448) p.out[O_PM + b * 8 + h] = m_prev;
  __syncthreads();
}
DI void mlstm_sample_item(const Params& p, LAS unsigned char* lds, int item) {
  const int tid = TID(), lane = tid & 63, w = tid >> 6;
  const int h = item & 7, b = item >> 3;
  const bf16* Y1 = (const bf16*)(p.ws + WS_Y1);
  const float* G4 = (const float*)(p.ws + WS_G4);
  bf16* HB = (bf16*)(p.ws + WS_HB);
  LAS float* qs = (LAS float*)lds; LAS float* ks = (LAS float*)(lds + 8192); LAS float* vs = (LAS float*)(lds + 16384);
  LAS float* red = (LAS float*)(lds + 24576); LAS float* n0 = (LAS float*)(lds + 90112);
  LAS float* M = (LAS float*)(lds + 91136);
  const size_t row0 = (size_t)NPR + (size_t)b * 8;
  { const int t = tid >> 6, c4 = (tid & 63) * 4;
    const u32x2 a = *(const u32x2*)(Y1 + (row0 + t) * LDY + C_QM + h * 256 + c4);
    const u32x2 k2 = *(const u32x2*)(Y1 + (row0 + t) * LDY + C_KM + h * 256 + c4);
    const u32x2 v2 = *(const u32x2*)(Y1 + (row0 + t) * LDY + C_VM + h * 256 + c4);
    *(LAS f32x4*)(qs + t * 256 + c4) = (f32x4){bflo(a.x), bfhi(a.x), bflo(a.y), bfhi(a.y)};
    *(LAS f32x4*)(ks + t * 256 + c4) = (f32x4){bflo(k2.x) * 0.0625f, bfhi(k2.x) * 0.0625f, bflo(k2.y) * 0.0625f, bfhi(k2.y) * 0.0625f};
    *(LAS f32x4*)(vs + t * 256 + c4) = (f32x4){bflo(v2.x), bfhi(v2.x), bflo(v2.y), bfhi(v2.y)};
    if (tid < 256) n0[tid] = p.in[I_SN][(size_t)item * 256 + tid];
    if (tid < 8) { float si = 0.f, sf = 0.f;
      for (int k4 = 0; k4 < 4; ++k4) { si += G4[((size_t)k4 * NTOK + row0 + tid) * 16 + h]; sf += G4[((size_t)k4 * NTOK + row0 + tid) * 16 + 8 + h]; }
      const float xf = sf + p.in[I_BIF][8 + h];
      M[tid] = si + p.in[I_BIF][h]; M[8 + tid] = fminf(xf, 0.f) - log1pf(__expf(-fabsf(xf))); }
  }
  __syncthreads();
  if (tid < 8) {
    const float m0 = p.in[I_SM][item];
    float bc = 0.f, pm = -3.0e38f, bct = 0.f, pmt = 0.f;
#pragma unroll
    for (int s2 = 0; s2 < 8; ++s2) { bc += M[8 + s2]; pm = fmaxf(pm, M[s2] - bc); if (s2 == tid) { bct = bc; pmt = pm; } }
    const float a = bct + m0, mt = fmaxf(a, bct + pmt), m_new = fmaxf(bc + m0, bc + pm);
    M[128 + tid] = bct; M[16 + tid] = mt; M[24 + tid] = __expf(a - mt); M[32 + tid] = __expf(bc - bct + M[tid] - m_new);
    if (tid == 0) { M[40] = __expf(bc + m0 - m_new); M[41] = m_new; }
  }
  __syncthreads();
  {
    const int t = w; const f32x4 qv = *(const LAS f32x4*)(qs + t * 256 + lane * 4);
    float pr[9];
#pragma unroll
    for (int s2 = 0; s2 < 8; ++s2) { const f32x4 kv = *(const LAS f32x4*)(ks + s2 * 256 + lane * 4); pr[s2] = (qv[0] * kv[0] + qv[1] * kv[1]) + (qv[2] * kv[2] + qv[3] * kv[3]); }
    { const f32x4 nv = *(const LAS f32x4*)(n0 + lane * 4); pr[8] = (qv[0] * nv[0] + qv[1] * nv[1]) + (qv[2] * nv[2] + qv[3] * nv[3]); }
#pragma unroll
    for (int o = 1; o < 64; o <<= 1) {
#pragma unroll
      for (int s2 = 0; s2 < 9; ++s2) pr[s2] += __shfl_xor(pr[s2], o);
    }
    if (lane == 0) {
#pragma unroll
      for (int s2 = 0; s2 < 8; ++s2) M[64 + t * 8 + s2] = (s2 <= t) ? pr[s2] * __expf(M[128 + t] - M[128 + s2] + M[s2] - M[16 + t]) : 0.f;
      M[48 + t] = pr[8];
    }
  }
  const float decay = M[40];
  const int e4 = lane * 4;
  f32x4 wv[8], num[8];
#pragma unroll
  for (int s = 0; s < 8; ++s) { wv[s] = *(const LAS f32x4*)(vs + s * 256 + e4) * M[32 + s]; num[s] = (f32x4){0.f, 0.f, 0.f, 0.f}; }
  const float* C0 = p.in[I_SC] + (size_t)item * 65536;
  float* C1 = p.out + O_SC + (size_t)item * 65536;
#pragma unroll 1
  for (int i0 = 0; i0 < 32; i0 += 8) {
    f32x4 cb[8];
#pragma unroll
    for (int u = 0; u < 8; ++u) cb[u] = __builtin_nontemporal_load((const f32x4*)(C0 + (size_t)(w + 8 * (i0 + u)) * 256 + e4));
#pragma unroll
    for (int u = 0; u < 8; ++u) {
      const int d = w + 8 * (i0 + u);
      const f32x4 c4 = cb[u];
      f32x4 cn = c4 * decay;
#pragma unroll
      for (int t = 0; t < 8; ++t) { const float qd = qs[t * 256 + d], kd = ks[t * 256 + d]; num[t] += c4 * qd; cn += wv[t] * kd; }
      __builtin_nontemporal_store(cn, (f32x4*)(C1 + (size_t)d * 256 + e4));
    }
  }
#pragma unroll
  for (int t = 0; t < 8; ++t) *(LAS f32x4*)(red + (w * 8 + t) * 256 + e4) = num[t];
  __syncthreads();
  { const int t = w;
    f32x4 nc = {0.f, 0.f, 0.f, 0.f};
#pragma unroll
    for (int w2 = 0; w2 < 8; ++w2) nc += *(const LAS f32x4*)(red + (w2 * 8 + t) * 256 + e4);
    f32x4 sv = {0.f, 0.f, 0.f, 0.f}; float ss = 0.f;
#pragma unroll
    for (int s = 0; s < 8; ++s) { const float S = M[64 + t * 8 + s]; sv += *(const LAS f32x4*)(vs + s * 256 + e4) * S; ss += S; }
    const float inter = M[24 + t], den = ss + inter * M[48 + t], dn = fmaxf(fabsf(den), __expf(-M[16 + t])), rd = rcpf_(dn);
    const u32x2 o2 = *(const u32x2*)(Y1 + (row0 + t) * LDY + C_OM + h * 256 + e4);
    const f32x4 hv = (sv + nc * inter) * rd;
    u32x2 o; o.x = pk2(sigm(bflo(o2.x)) * hv[0], sigm(bfhi(o2.x)) * hv[1]); o.y = pk2(sigm(bflo(o2.y)) * hv[2], sigm(bfhi(o2.y)) * hv[3]);
    *(u32x2*)(HB + (row0 + t) * 2048 + h * 256 + e4) = o;
  }
  if (tid < 256) { float nn = decay * n0[tid];
#pragma unroll
    for (int s = 0; s < 8; ++s) nn += M[32 + s] * ks[s * 256 + tid];
    p.out[O_SN + (size_t)item * 256 + tid] = nn; }
  if (tid == 0) p.out[O_SM + item] = M[41];
  __syncthreads();
}

constexpr int AT_K = 0, AT_VT = 23040, AT_END = 23040 + 64 * 336;
DI void attn_wave(const LAS unsigned char* lds, bf16x8 qf0, bf16x8 qf1, int klo, int khi, float sink, f32x4 (&o)[4]) {
  const int lane = TID() & 63, r = lane & 15, q = lane >> 4;
  f32x4 s[10];
#pragma unroll
  for (int kt = 0; kt < 10; ++kt) {
    const bf16x8 a0 = *(const LAS bf16x8*)(lds + AT_K + (kt * 16 + r) * 144 + q * 16), a1 = *(const LAS bf16x8*)(lds + AT_K + (kt * 16 + r) * 144 + 64 + q * 16);
    f32x4 acc = {0.f, 0.f, 0.f, 0.f};
    acc = MFMA16(a0, qf0, acc); acc = MFMA16(a1, qf1, acc);
    s[kt] = acc;
  }
  float mx = sink;
#pragma unroll
  for (int kt = 0; kt < 10; ++kt)
#pragma unroll
    for (int g = 0; g < 4; ++g) { const int j = kt * 16 + 4 * q + g; const bool ok = (j >= klo) && (j <= khi); s[kt][g] = ok ? s[kt][g] * 0.125f : -3.0e38f; mx = fmaxf(mx, s[kt][g]); }
  mx = fmaxf(mx, __shfl_xor(mx, 16)); mx = fmaxf(mx, __shfl_xor(mx, 32));
  float sum = 0.f;
#pragma unroll
  for (int kt = 0; kt < 10; ++kt)
#pragma unroll
    for (int g = 0; g < 4; ++g) { const float pv = s[kt][g] > -1.0e38f ? __expf(s[kt][g] - mx) : 0.f; s[kt][g] = pv; sum += pv; }
  sum += __shfl_xor(sum, 16); sum += __shfl_xor(sum, 32);
  const float rden = rcpf_(sum + __expf(sink - mx));
#pragma unroll
  for (int dt = 0; dt < 4; ++dt) o[dt] = (f32x4){0.f, 0.f, 0.f, 0.f};
#pragma unroll
  for (int u = 0; u < 5; ++u) {
    u32x4 pw; pw.x = pk2(s[2 * u][0], s[2 * u][1]); pw.y = pk2(s[2 * u][2], s[2 * u][3]); pw.z = pk2(s[2 * u + 1][0], s[2 * u + 1][1]); pw.w = pk2(s[2 * u + 1][2], s[2 * u + 1][3]);
    const bf16x8 pb = __builtin_bit_cast(bf16x8, pw);
#pragma unroll
    for (int dt = 0; dt < 4; ++dt) {
      const u32x2 lo = *(const LAS u32x2*)(lds + AT_VT + (dt * 16 + r) * 336 + (u * 32 + 4 * q) * 2), hi = *(const LAS u32x2*)(lds + AT_VT + (dt * 16 + r) * 336 + (u * 32 + 16 + 4 * q) * 2);
      u32x4 aw; aw.x = lo.x; aw.y = lo.y; aw.z = hi.x; aw.w = hi.y;
      o[dt] = MFMA16(__builtin_bit_cast(bf16x8, aw), pb, o[dt]);
    }
  }
#pragma unroll
  for (int dt = 0; dt < 4; ++dt) o[dt] *= rden;
}
DI void rope8(const u32x4 x1, const u32x4 x2, const float* rt, int i0, float (&o1)[8], float (&o2)[8]) {
  const f32x4 c0 = *(const f32x4*)(rt + i0), c1 = *(const f32x4*)(rt + i0 + 4), s0 = *(const f32x4*)(rt + 32 + i0), s1 = *(const f32x4*)(rt + 32 + i0 + 4);
  const float a[8] = {bflo(x1.x), bfhi(x1.x), bflo(x1.y), bfhi(x1.y), bflo(x1.z), bfhi(x1.z), bflo(x1.w), bfhi(x1.w)};
  const float bb[8] = {bflo(x2.x), bfhi(x2.x), bflo(x2.y), bfhi(x2.y), bflo(x2.z), bfhi(x2.z), bflo(x2.w), bfhi(x2.w)};
  const float cs[8] = {c0[0], c0[1], c0[2], c0[3], c1[0], c1[1], c1[2], c1[3]}, sn[8] = {s0[0], s0[1], s0[2], s0[3], s1[0], s1[1], s1[2], s1[3]};
#pragma unroll
  for (int j = 0; j < 8; ++j) { o1[j] = a[j] * cs[j] - bb[j] * sn[j]; o2[j] = bb[j] * cs[j] + a[j] * sn[j]; }
}
DI void rope8r(const u32x4 x1, const u32x4 x2, const f32x4 (&t)[4], float (&o1)[8], float (&o2)[8]) {
  const float a[8] = {bflo(x1.x), bfhi(x1.x), bflo(x1.y), bfhi(x1.y), bflo(x1.z), bfhi(x1.z), bflo(x1.w), bfhi(x1.w)};
  const float bb[8] = {bflo(x2.x), bfhi(x2.x), bflo(x2.y), bfhi(x2.y), bflo(x2.z), bfhi(x2.z), bflo(x2.w), bfhi(x2.w)};
#pragma unroll
  for (int j = 0; j < 8; ++j) { const float c = t[j >> 2][j & 3], sn = t[2 + (j >> 2)][j & 3]; o1[j] = a[j] * c - bb[j] * sn; o2[j] = bb[j] * c + a[j] * sn; }
}
DI u32x4 pack8(const float (&v)[8]) { u32x4 o; o.x = pk2(v[0], v[1]); o.y = pk2(v[2], v[3]); o.z = pk2(v[4], v[5]); o.w = pk2(v[6], v[7]); return o; }
DI void attn_store(const Params& p, const f32x4 (&o)[4], size_t row, int head) {
  const int lane = TID() & 63, q = lane >> 4;
  const bf16* Y1 = (const bf16*)(p.ws + WS_Y1); bf16* MIX = (bf16*)(p.ws + WS_MIX);
#pragma unroll
  for (int dt = 0; dt < 4; ++dt) {
    const u32x2 z = *(const u32x2*)(Y1 + row * LDY + C_ZA + head * 64 + dt * 16 + 4 * q);
    const float z0 = bflo(z.x), z1 = bfhi(z.x), z2 = bflo(z.y), z3 = bfhi(z.y);
    u32x2 w; w.x = pk2(o[dt][0] * z0 * sigm(z0), o[dt][1] * z1 * sigm(z1)); w.y = pk2(o[dt][2] * z2 * sigm(z2), o[dt][3] * z3 * sigm(z3));
    *(u32x2*)(MIX + row * DM + 2048 + head * 64 + dt * 16 + 4 * q) = w;
  }
}
DI void attn_store_z(const Params& p, const f32x4 (&o)[4], const u32x2 (&zz)[4], size_t row, int head) {
  const int lane = TID() & 63, q = lane >> 4;
  bf16* MIX = (bf16*)(p.ws + WS_MIX);
#pragma unroll
  for (int dt = 0; dt < 4; ++dt) {
    const float z0 = bflo(zz[dt].x), z1 = bfhi(zz[dt].x), z2 = bflo(zz[dt].y), z3 = bfhi(zz[dt].y);
    u32x2 w; w.x = pk2(o[dt][0] * z0 * sigm(z0), o[dt][1] * z1 * sigm(z1)); w.y = pk2(o[dt][2] * z2 * sigm(z2), o[dt][3] * z3 * sigm(z3));
    *(u32x2*)(MIX + row * DM + 2048 + head * 64 + dt * 16 + 4 * q) = w;
  }
}
DI void attn_prompt_item(const Params& p, LAS unsigned char* lds, int item) {
  const int tid = TID(), lane = tid & 63, w = tid >> 6, r = lane & 15, q = lane >> 4;
  const int kvh = item & 7, qb = (item >> 3) & 63, b = item >> 9, q0 = qb * 32;
  const bf16* Y1 = (const bf16*)(p.ws + WS_Y1); const float* RT = (const float*)(p.ws + WS_ROPE);
  const size_t rowb = (size_t)b * SEQ;
  const int g = w >> 1, qt = w & 1, head = kvh * 4 + g, qpos = q0 + qt * 16 + r;
  u32x4 kx1[2], kx2[2]; f32x4 kc[2][4]; unsigned vv[2][8]; u32x4 qx1, qx2; f32x4 qc[4]; u32x2 zz[4];
#pragma unroll
  for (int t = 0; t < 2; ++t) {
    const int task = tid + 512 * t, j = task >> 2, c4 = task & 3, pos = q0 - 128 + j;
    kx1[t] = (u32x4){0u, 0u, 0u, 0u}; kx2[t] = kx1[t];
#pragma unroll
    for (int i = 0; i < 4; ++i) kc[t][i] = (f32x4){0.f, 0.f, 0.f, 0.f};
    if (task < 640 && pos >= 0) { const bf16* src = Y1 + (rowb + pos) * LDY + C_KA + kvh * 64 + c4 * 8; kx1[t] = *(const u32x4*)src; kx2[t] = *(const u32x4*)(src + 32);
      const float* rt = RT + pos * 64 + c4 * 8; kc[t][0] = *(const f32x4*)rt; kc[t][1] = *(const f32x4*)(rt + 4); kc[t][2] = *(const f32x4*)(rt + 32); kc[t][3] = *(const f32x4*)(rt + 36); }
    const int dpp = task & 31, kg = task >> 5;
#pragma unroll
    for (int i = 0; i < 8; ++i) { const int vpos = q0 - 128 + kg * 8 + i; vv[t][i] = (task < 640 && vpos >= 0) ? *(const unsigned*)(Y1 + (rowb + vpos) * LDY + C_VA + kvh * 64 + 2 * dpp) : 0u; }
  }
  { const bf16* src = Y1 + (rowb + qpos) * LDY + C_QA + head * 64 + q * 8; qx1 = *(const u32x4*)src; qx2 = *(const u32x4*)(src + 32);
    const float* rt = RT + qpos * 64 + q * 8; qc[0] = *(const f32x4*)rt; qc[1] = *(const f32x4*)(rt + 4); qc[2] = *(const f32x4*)(rt + 32); qc[3] = *(const f32x4*)(rt + 36);
#pragma unroll
    for (int dt = 0; dt < 4; ++dt) zz[dt] = *(const u32x2*)(Y1 + (rowb + qpos) * LDY + C_ZA + head * 64 + dt * 16 + 4 * q); }
#pragma unroll
  for (int t = 0; t < 2; ++t) {
    const int task = tid + 512 * t;
    if (task < 640) {
      const int j = task >> 2, c4 = task & 3, pos = q0 - 128 + j;
      float o1[8], o2[8]; rope8r(kx1[t], kx2[t], kc[t], o1, o2);
      const u32x4 w1 = pack8(o1), w2 = pack8(o2);
      if (pos >= SEQ - 128 && j >= 128) { float* dst = p.out + O_PK + (((size_t)b * 128 + (pos - (SEQ - 128))) * 8 + kvh) * 64 + c4 * 8;
        *(f32x4*)dst = (f32x4){o1[0], o1[1], o1[2], o1[3]}; *(f32x4*)(dst + 4) = (f32x4){o1[4], o1[5], o1[6], o1[7]};
        *(f32x4*)(dst + 32) = (f32x4){o2[0], o2[1], o2[2], o2[3]}; *(f32x4*)(dst + 36) = (f32x4){o2[4], o2[5], o2[6], o2[7]}; }
      *(LAS u32x4*)(lds + AT_K + j * 144 + c4 * 16) = w1; *(LAS u32x4*)(lds + AT_K + j * 144 + 64 + c4 * 16) = w2;
      const int dpp = task & 31, kg = task >> 5;
#pragma unroll
      for (int i = 0; i < 8; ++i) { const int vpos = q0 - 128 + kg * 8 + i;
        if (vpos >= SEQ - 128 && kg >= 16) *(f32x2*)(p.out + O_PV + (((size_t)b * 128 + (vpos - (SEQ - 128))) * 8 + kvh) * 64 + 2 * dpp) = (f32x2){bflo(vv[t][i]), bfhi(vv[t][i])}; }
      u32x4 a, bq;
      a.x = (vv[t][0] & 0xffffu) | (vv[t][1] << 16); a.y = (vv[t][2] & 0xffffu) | (vv[t][3] << 16); a.z = (vv[t][4] & 0xffffu) | (vv[t][5] << 16); a.w = (vv[t][6] & 0xffffu) | (vv[t][7] << 16);
      bq.x = (vv[t][0] >> 16) | (vv[t][1] & 0xffff0000u); bq.y = (vv[t][2] >> 16) | (vv[t][3] & 0xffff0000u); bq.z = (vv[t][4] >> 16) | (vv[t][5] & 0xffff0000u); bq.w = (vv[t][6] >> 16) | (vv[t][7] & 0xffff0000u);
      *(LAS u32x4*)(lds + AT_VT + (2 * dpp) * 336 + kg * 16) = a; *(LAS u32x4*)(lds + AT_VT + (2 * dpp + 1) * 336 + kg * 16) = bq;
    }
  }
  bf16x8 qf0, qf1;
  { float o1[8], o2[8]; rope8r(qx1, qx2, qc, o1, o2); qf0 = __builtin_bit_cast(bf16x8, pack8(o1)); qf1 = __builtin_bit_cast(bf16x8, pack8(o2)); }
  __syncthreads();
  f32x4 o[4];
  const int klo0 = qt * 16 + r + 1, kmin = 128 - q0;
  attn_wave(lds, qf0, qf1, klo0 > kmin ? klo0 : kmin, qt * 16 + r + 128, p.in[I_SINK][head], o);
  attn_store_z(p, o, zz, rowb + qpos, head);
  __syncthreads();
}
DI void attn_sample_item(const Params& p, LAS unsigned char* lds, int item) {
  const int tid = TID(), lane = tid & 63, w = tid >> 6, r = lane & 15, q = lane >> 4;
  const int kvh = item & 7, b = item >> 3;
  const bf16* Y1 = (const bf16*)(p.ws + WS_Y1); const float* RT = (const float*)(p.ws + WS_ROPE);
  const size_t rowb = (size_t)NPR + (size_t)b * 8;
  const float* CK = p.in[I_CK] + (size_t)b * 128 * 512 + kvh * 64; const float* CV = p.in[I_CV] + (size_t)b * 128 * 512 + kvh * 64;
  float* OK = p.out + O_SK + (size_t)b * 128 * 512 + kvh * 64; float* OV = p.out + O_SV + (size_t)b * 128 * 512 + kvh * 64;
  const int jA = tid >> 2, c4 = tid & 3, jB = 128 + (tid >> 2), dpp = tid & 31, kgA = tid >> 5, kgB = 16 + (tid >> 5);
  const float* srcA = CK + (size_t)jA * 512 + c4 * 8;
  const f32x4 ka0 = __builtin_nontemporal_load((const f32x4*)srcA), ka1 = __builtin_nontemporal_load((const f32x4*)(srcA + 4)), kb0 = __builtin_nontemporal_load((const f32x4*)(srcA + 32)), kb1 = __builtin_nontemporal_load((const f32x4*)(srcA + 36));
  u32x4 nx1 = {0u, 0u, 0u, 0u}, nx2 = {0u, 0u, 0u, 0u}; f32x4 nc[4];
#pragma unroll
  for (int i = 0; i < 4; ++i) nc[i] = (f32x4){0.f, 0.f, 0.f, 0.f};
  if (tid < 32) { const int t = jB - 128; const bf16* src = Y1 + (rowb + t) * LDY + C_KA + kvh * 64 + c4 * 8; nx1 = *(const u32x4*)src; nx2 = *(const u32x4*)(src + 32);
    const float* rt = RT + (SEQ + t) * 64 + c4 * 8; nc[0] = *(const f32x4*)rt; nc[1] = *(const f32x4*)(rt + 4); nc[2] = *(const f32x4*)(rt + 32); nc[3] = *(const f32x4*)(rt + 36); }
  f32x2 va[8]; unsigned vb[8];
#pragma unroll
  for (int i = 0; i < 8; ++i) { va[i] = __builtin_nontemporal_load((const f32x2*)(CV + (size_t)(kgA * 8 + i) * 512 + 2 * dpp)); vb[i] = 0u; }
  if (tid < 32) {
#pragma unroll
    for (int i = 0; i < 8; ++i) vb[i] = *(const unsigned*)(Y1 + (rowb + i) * LDY + C_VA + kvh * 64 + 2 * dpp); }
  const int g = 2 * (w & 1) + (r >> 3), tq = r & 7, head = kvh * 4 + g;
  u32x4 qx1 = {0u, 0u, 0u, 0u}, qx2 = {0u, 0u, 0u, 0u}; f32x4 qc[4]; u32x2 zz[4];
#pragma unroll
  for (int i = 0; i < 4; ++i) { qc[i] = (f32x4){0.f, 0.f, 0.f, 0.f}; zz[i] = (u32x2){0u, 0u}; }
  if (w < 2) { const bf16* src = Y1 + (rowb + tq) * LDY + C_QA + head * 64 + q * 8; qx1 = *(const u32x4*)src; qx2 = *(const u32x4*)(src + 32);
    const float* rt = RT + (SEQ + tq) * 64 + q * 8; qc[0] = *(const f32x4*)rt; qc[1] = *(const f32x4*)(rt + 4); qc[2] = *(const f32x4*)(rt + 32); qc[3] = *(const f32x4*)(rt + 36);
#pragma unroll
    for (int dt = 0; dt < 4; ++dt) zz[dt] = *(const u32x2*)(Y1 + (rowb + tq) * LDY + C_ZA + head * 64 + dt * 16 + 4 * q); }
  asm volatile("" ::: "memory");
  { const float o1[8] = {ka0[0], ka0[1], ka0[2], ka0[3], ka1[0], ka1[1], ka1[2], ka1[3]}, o2[8] = {kb0[0], kb0[1], kb0[2], kb0[3], kb1[0], kb1[1], kb1[2], kb1[3]};
    *(LAS u32x4*)(lds + AT_K + jA * 144 + c4 * 16) = pack8(o1); *(LAS u32x4*)(lds + AT_K + jA * 144 + 64 + c4 * 16) = pack8(o2);
    if (jA >= 8) { float* dst = OK + (size_t)(jA - 8) * 512 + c4 * 8; __builtin_nontemporal_store(ka0, (f32x4*)dst); __builtin_nontemporal_store(ka1, (f32x4*)(dst + 4)); __builtin_nontemporal_store(kb0, (f32x4*)(dst + 32)); __builtin_nontemporal_store(kb1, (f32x4*)(dst + 36)); } }
  if (tid < 128) {
    u32x4 w1 = {0u, 0u, 0u, 0u}, w2 = {0u, 0u, 0u, 0u};
    if (tid < 32) { float o1[8], o2[8]; rope8r(nx1, nx2, nc, o1, o2); w1 = pack8(o1); w2 = pack8(o2);
      float* dst = OK + (size_t)(jB - 8) * 512 + c4 * 8;
      *(f32x4*)dst = (f32x4){o1[0], o1[1], o1[2], o1[3]}; *(f32x4*)(dst + 4) = (f32x4){o1[4], o1[5], o1[6], o1[7]};
      *(f32x4*)(dst + 32) = (f32x4){o2[0], o2[1], o2[2], o2[3]}; *(f32x4*)(dst + 36) = (f32x4){o2[4], o2[5], o2[6], o2[7]}; }
    *(LAS u32x4*)(lds + AT_K + jB * 144 + c4 * 16) = w1; *(LAS u32x4*)(lds + AT_K + jB * 144 + 64 + c4 * 16) = w2;
  }
  { float v0[8], v1[8];
#pragma unroll
    for (int i = 0; i < 8; ++i) { v0[i] = va[i].x; v1[i] = va[i].y; const int j = kgA * 8 + i; if (j >= 8) __builtin_nontemporal_store(va[i], (f32x2*)(OV + (size_t)(j - 8) * 512 + 2 * dpp)); }
    *(LAS u32x4*)(lds + AT_VT + (2 * dpp) * 336 + kgA * 16) = pack8(v0); *(LAS u32x4*)(lds + AT_VT + (2 * dpp + 1) * 336 + kgA * 16) = pack8(v1); }
  if (tid < 128) { float v0[8], v1[8];
#pragma unroll
    for (int i = 0; i < 8; ++i) { v0[i] = bflo(vb[i]); v1[i] = bfhi(vb[i]); if (tid < 32) *(f32x2*)(OV + (size_t)(120 + i) * 512 + 2 * dpp) = (f32x2){v0[i], v1[i]}; }
    *(LAS u32x4*)(lds + AT_VT + (2 * dpp) * 336 + kgB * 16) = pack8(v0); *(LAS u32x4*)(lds + AT_VT + (2 * dpp + 1) * 336 + kgB * 16) = pack8(v1); }
  __syncthreads();
  if (w < 2) {
    bf16x8 qf0, qf1;
    { float o1[8], o2[8]; rope8r(qx1, qx2, qc, o1, o2); qf0 = __builtin_bit_cast(bf16x8, pack8(o1)); qf1 = __builtin_bit_cast(bf16x8, pack8(o2)); }
    f32x4 o[4];
    attn_wave(lds, qf0, qf1, tq + 1, tq + 128, p.in[I_SINK][head], o);
    attn_store_z(p, o, zz, rowb + tq, head);
  }
  __syncthreads();
}
DI void phase_mixers(const Params& p, LAS unsigned char* lds) {
#ifndef ONLYIT
#define ONLYIT -1
#endif
#define ITON(k) (ONLYIT == -1 || ONLYIT == (k))
  if constexpr (ITON(0)) for (int it = BID(); it < 256; it += gridDim.x) mlstm_prompt_item(p, lds, it);
#ifdef DOUBLE_MP
  if constexpr (ITON(0)) for (int it = BID(); it < 256; it += gridDim.x) mlstm_prompt_item(p, lds, it);
#endif
#ifdef PROBE_SEL
  if (blockIdx.x == 0 && threadIdx.x == 0) ((LAS unsigned long long*)(lds + 163840 - 128))[9] = __builtin_amdgcn_s_memrealtime();
#endif
  constexpr int N_MS = 1024, N_AP = 4 * 64 * 8, N_AS = 1024;
  const int nround = (N_MS + N_AP + N_AS + (int)gridDim.x - 1) / (int)gridDim.x;
  for (int jj = 0; jj < nround; ++jj) {
    const int it = ((jj + BID()) % nround) * (int)gridDim.x + BID();
    if (it >= N_MS + N_AP + N_AS) continue;
    if (it < N_MS) { if constexpr (ITON(1)) { mlstm_sample_item(p, lds, it);
#ifdef DOUBLE_MS
      mlstm_sample_item(p, lds, it);
#endif
    } }
    else if (it < N_MS + N_AP) { if constexpr (ITON(2)) attn_prompt_item(p, lds, it - N_MS); }
    else { if constexpr (ITON(3)) attn_sample_item(p, lds, it - N_MS - N_AP); }
  }
}
DI void phase_headnorm(const Params& p) {
  const int lane = TID() & 63, gw = BID() * 8 + (TID() >> 6), NGW = gridDim.x * 8;
  const bf16* Y1 = (const bf16*)(p.ws + WS_Y1); const bf16* HB = (const bf16*)(p.ws + WS_HB); bf16* MIX = (bf16*)(p.ws + WS_MIX);
  for (int it0 = gw; it0 < NTOK * 8; it0 += 4 * NGW) {
    u32x2 hv4[4], zv4[4];
#pragma unroll
    for (int u = 0; u < 4; ++u) { const int it = it0 + u * NGW; const int row = it >> 3, h = it & 7;
      if (it < NTOK * 8) { hv4[u] = *(const u32x2*)(HB + (size_t)row * 2048 + h * 256 + lane * 4); zv4[u] = *(const u32x2*)(Y1 + (size_t)row * LDY + C_ZM + h * 256 + lane * 4); } }
    asm volatile("" ::: "memory");
#pragma unroll
    for (int u = 0; u < 4; ++u) { const int it = it0 + u * NGW; if (it >= NTOK * 8) break;
      const int row = it >> 3, h = it & 7;
      const u32x2 hv = hv4[u], zv = zv4[u];
      const f32x4 g = *(const f32x4*)(p.in[I_NMG] + h * 256 + lane * 4);
      float x[4] = {bflo(hv.x), bfhi(hv.x), bflo(hv.y), bfhi(hv.y)};
      const float z[4] = {bflo(zv.x), bfhi(zv.x), bflo(zv.y), bfhi(zv.y)};
      const float mu = wave_sum((x[0] + x[1]) + (x[2] + x[3])) * (1.f / 256.f);
      float s2 = 0.f;
#pragma unroll
      for (int j = 0; j < 4; ++j) { x[j] -= mu; s2 += x[j] * x[j]; }
      const float rstd = __builtin_amdgcn_rsqf(wave_sum(s2) * (1.f / 256.f) + 1e-5f);
      float o[4];
#pragma unroll
      for (int j = 0; j < 4; ++j) o[j] = x[j] * rstd * g[j] * z[j] * sigm(z[j]);
      u32x2 w; w.x = pk2(o[0], o[1]); w.y = pk2(o[2], o[3]);
      *(u32x2*)(MIX + (size_t)row * DM + h * 256 + lane * 4) = w;
    }
  }
}
DI void phase_reduce2(const Params& p) {
  const bf16* Y1 = (const bf16*)(p.ws + WS_Y1); bf16* MRG = (bf16*)(p.ws + WS_MRG); const float* P2 = (const float*)(p.ws + WS_P2);
  for (int idx = BID() * 512 + TID(); idx < 1024 * 512; idx += gridDim.x * 512) {
    const int r = idx >> 9, c8 = (idx & 511) * 8; const size_t row = NPR + r;
    const float* q = P2 + (size_t)r * DM + c8;
    const f32x4 m0 = *(const f32x4*)q + *(const f32x4*)(q + (size_t)1024 * DM), m1 = *(const f32x4*)(q + 4) + *(const f32x4*)(q + (size_t)1024 * DM + 4);
    const f32x4 a0 = *(const f32x4*)(q + (size_t)2048 * DM) + *(const f32x4*)(q + (size_t)3072 * DM), a1 = *(const f32x4*)(q + (size_t)2048 * DM + 4) + *(const f32x4*)(q + (size_t)3072 * DM + 4);
    const u32x4 gm = *(const u32x4*)(Y1 + row * LDY + C_GM + c8), ga = *(const u32x4*)(Y1 + row * LDY + C_GA + c8);
    u32x4 w;
    w.x = pk2(sigm(bflo(gm.x)) * m0[0] + sigm(bflo(ga.x)) * a0[0], sigm(bfhi(gm.x)) * m0[1] + sigm(bfhi(ga.x)) * a0[1]);
    w.y = pk2(sigm(bflo(gm.y)) * m0[2] + sigm(bflo(ga.y)) * a0[2], sigm(bfhi(gm.y)) * m0[3] + sigm(bfhi(ga.y)) * a0[3]);
    w.z = pk2(sigm(bflo(gm.z)) * m1[0] + sigm(bflo(ga.z)) * a1[0], sigm(bfhi(gm.z)) * m1[1] + sigm(bfhi(ga.z)) * a1[1]);
    w.w = pk2(sigm(bflo(gm.w)) * m1[2] + sigm(bflo(ga.w)) * a1[2], sigm(bfhi(gm.w)) * m1[3] + sigm(bfhi(ga.w)) * a1[3]);
    *(u32x4*)(MRG + row * DM + c8) = w;
  }
}
DI void phase_ln(const Params& p) {
  const int lane = TID() & 63, gw = BID() * 8 + (TID() >> 6), NGW = gridDim.x * 8;
  f32x4 G[16], Bv[16];
#pragma unroll
  for (int j = 0; j < 16; ++j) { G[j] = *(const f32x4*)(p.in[I_LNG] + j * 256 + lane * 4); Bv[j] = *(const f32x4*)(p.in[I_LNB] + j * 256 + lane * 4); }
  for (int row = gw; row < NTOK; row += NGW) {
    float* y = p.out + (size_t)row * DM;
    f32x4 v[16]; float s = 0.f;
#pragma unroll
    for (int j = 0; j < 16; ++j) {
      if (row < NPR) { const u32x2 zz = *(const u32x2*)((const bf16*)(p.ws + WS_Z) + (size_t)row * DM + j * 256 + lane * 4); v[j] = (f32x4){bflo(zz.x), bfhi(zz.x), bflo(zz.y), bfhi(zz.y)}; }
      else { const float* P3 = (const float*)(p.ws + WS_P3) + (size_t)(row - NPR) * DM + j * 256 + lane * 4;
        v[j] = *(const f32x4*)(p.in[I_XS] + (size_t)(row - NPR) * DM + j * 256 + lane * 4) * 1.18920711500272106672f
             + ((*(const f32x4*)P3 + *(const f32x4*)(P3 + (size_t)1024 * DM)) + (*(const f32x4*)(P3 + (size_t)2048 * DM) + *(const f32x4*)(P3 + (size_t)3072 * DM))); }
      s += (v[j][0] + v[j][1]) + (v[j][2] + v[j][3]); }
    const float mu = wave_sum(s) * (1.f / DM); float s2 = 0.f;
#pragma unroll
    for (int j = 0; j < 16; ++j) { v[j] = v[j] - mu; s2 += (v[j][0] * v[j][0] + v[j][1] * v[j][1]) + (v[j][2] * v[j][2] + v[j][3] * v[j][3]); }
    const float rstd = __builtin_amdgcn_rsqf(wave_sum(s2) * (1.f / DM) + 1e-5f);
#pragma unroll
    for (int j = 0; j < 16; ++j) __builtin_nontemporal_store(v[j] * rstd * G[j] + Bv[j], (f32x4*)(y + j * 256 + lane * 4));
  }
}
struct EpiMerged {
  static constexpr bool PERM = true, AFTER_DRAIN = false, HAS_MID = true; static constexpr int MID_T = 32;
  const bf16* Y1; bf16* O; float* P;
  DI void mid(f32x4 (&acc)[2][2][4][2], const pg8::Unit& u, int wr, int wc, int fr, int fq) const {
    int row0 = u.pm * 256 + wr * 64 + fr, col0 = u.pn * 256 + wc * 32 + 8 * fq;
    asm volatile("" : "+v"(row0), "+v"(col0));
#pragma unroll
    for (int ai = 0; ai < 2; ++ai)
#pragma unroll
      for (int m = 0; m < 4; ++m) { const size_t row = row0 + ai * 128 + m * 16;
#pragma unroll
        for (int bj = 0; bj < 2; ++bj) { const int col = col0 + bj * 128;
          const u32x4 gm = *(const u32x4*)(Y1 + row * LDY + C_GM + col), ga = *(const u32x4*)(Y1 + row * LDY + C_GA + col);
          const unsigned gmw[4] = {gm.x, gm.y, gm.z, gm.w}, gaw[4] = {ga.x, ga.y, ga.z, ga.w};
#pragma unroll
          for (int j = 0; j < 4; ++j) { const float r0 = (1.f + __expf(-bflo(gaw[j]))) * rcpf_(1.f + __expf(-bflo(gmw[j]))), r1 = (1.f + __expf(-bfhi(gaw[j]))) * rcpf_(1.f + __expf(-bfhi(gmw[j])));
            acc[ai][bj][m][j >> 1][(j & 1) * 2] *= r0; acc[ai][bj][m][j >> 1][(j & 1) * 2 + 1] *= r1; } }
        if (m & 1) asm volatile("" ::: "memory"); }
  }
  DI void operator()(const f32x4 (&acc)[2][2][4][2], const pg8::Unit& u, int wr, int wc, int fr, int fq) const {
    const int row0 = u.pm * 256 + wr * 64 + fr, col0 = u.pn * 256 + wc * 32 + 8 * fq;
    if (u.kind == 0) {
#pragma unroll
      for (int ai = 0; ai < 2; ++ai) {
        u32x4 gg[4][2];
#pragma unroll
        for (int m = 0; m < 4; ++m)
#pragma unroll
          for (int bj = 0; bj < 2; ++bj) gg[m][bj] = *(const u32x4*)(Y1 + (size_t)(row0 + ai * 128 + m * 16) * LDY + C_GA + col0 + bj * 128);
        asm volatile("" ::: "memory");
#pragma unroll
        for (int m = 0; m < 4; ++m) { const size_t row = row0 + ai * 128 + m * 16;
#pragma unroll
          for (int bj = 0; bj < 2; ++bj) { const int col = col0 + bj * 128;
            const u32x4 g = gg[m][bj];
            const f32x4 v0 = acc[ai][bj][m][0], v1 = acc[ai][bj][m][1];
            u32x4 w; w.x = pk2(sigm(bflo(g.x)) * v0[0], sigm(bfhi(g.x)) * v0[1]); w.y = pk2(sigm(bflo(g.y)) * v0[2], sigm(bfhi(g.y)) * v0[3]);
            w.z = pk2(sigm(bflo(g.z)) * v1[0], sigm(bfhi(g.z)) * v1[1]); w.w = pk2(sigm(bflo(g.w)) * v1[2], sigm(bfhi(g.w)) * v1[3]);
            *(u32x4*)(O + row * DM + col) = w; } } }
    } else {
      float* Pq = P + (size_t)(u.k0 / u.nk) * 1024 * DM;
#pragma unroll
      for (int ai = 0; ai < 2; ++ai)
#pragma unroll
        for (int m = 0; m < 4; ++m) { const size_t row = row0 + ai * 128 + m * 16 - NPR;
#pragma unroll
          for (int bj = 0; bj < 2; ++bj) { const int col = col0 + bj * 128;
            *(f32x4*)(Pq + row * DM + col) = acc[ai][bj][m][0]; *(f32x4*)(Pq + row * DM + col + 4) = acc[ai][bj][m][1]; } }
    }
  }
};
struct EpiOut {
  static constexpr bool PERM = false, AFTER_DRAIN = false, HAS_MID = false; static constexpr int MID_T = 0;
  const float* xp; const float* xs; bf16* Z; float* P;
  DI void operator()(const f32x4 (&acc)[2][2][4][2], const pg8::Unit& u, int wr, int wc, int fr, int fq) const {
    const int row0 = u.pm * 256 + wr * 64 + fr, col0 = u.pn * 256 + wc * 32 + 4 * fq;
    const float alpha = 1.18920711500272106672f;
    if (u.kind != 0) {
      float* Pq = P + (size_t)(u.k0 / u.nk) * 1024 * DM;
#pragma unroll
      for (int ai = 0; ai < 2; ++ai)
#pragma unroll
        for (int m = 0; m < 4; ++m) { const size_t row = row0 + ai * 128 + m * 16 - NPR;
#pragma unroll
          for (int bj = 0; bj < 2; ++bj)
#pragma unroll
            for (int n = 0; n < 2; ++n) *(f32x4*)(Pq + row * DM + col0 + bj * 128 + n * 16) = acc[ai][bj][m][n]; }
      return;
    }
#pragma unroll
    for (int ai = 0; ai < 2; ++ai) {
      f32x4 xv[4][2][2];
#pragma unroll
      for (int m = 0; m < 4; ++m) { const size_t row = row0 + ai * 128 + m * 16;
        const float* xr = row < NPR ? xp + row * DM : xs + (row - NPR) * DM;
#pragma unroll
        for (int bj = 0; bj < 2; ++bj)
#pragma unroll
          for (int n = 0; n < 2; ++n) xv[m][bj][n] = *(const f32x4*)(xr + col0 + bj * 128 + n * 16); }
      asm volatile("" ::: "memory");
#pragma unroll
      for (int m = 0; m < 4; ++m) { const size_t row = row0 + ai * 128 + m * 16;
#pragma unroll
        for (int bj = 0; bj < 2; ++bj)
#pragma unroll
          for (int n = 0; n < 2; ++n) { const int col = col0 + bj * 128 + n * 16;
            const f32x4 zv = xv[m][bj][n] * alpha + acc[ai][bj][m][n];
            u32x2 w; w.x = pk2(zv[0], zv[1]); w.y = pk2(zv[2], zv[3]);
            *(u32x2*)(Z + row * DM + col) = w; } }
    }
  }
};
#define XB_TMO      128
#define XB_XCNT(j)  (256  + 64 * (j))
#define XB_XSUB(j)  (1280 + 64 * (j))
#define XB_XGEN(j)  (2304 + 64 * (j))
#define XB_TOP      3328
#define XB_TOPGEN   3392
#define XCD_BAR_WORDS 3456
#define XB_SPIN_CAP (1u << 18)

__device__ __forceinline__ unsigned xb_ld(unsigned* p)              { return __hip_atomic_load(p, __ATOMIC_RELAXED, __HIP_MEMORY_SCOPE_AGENT); }
__device__ __forceinline__ unsigned xb_add(unsigned* p, unsigned v) { return __hip_atomic_fetch_add(p, v, __ATOMIC_RELAXED, __HIP_MEMORY_SCOPE_AGENT); }
__device__ __forceinline__ unsigned xb_xcc_id() { return (unsigned)__builtin_amdgcn_s_getreg((3 << 11) | 20) & 0xFu; }
#define XB_SPIN(cond, bar) do { unsigned _sp = 0; while (cond) { __builtin_amdgcn_s_sleep(1); \
    if ((++_sp & 255u) == 0u) { if (xb_ld(&(bar)[XB_TMO])) break; if (_sp > XB_SPIN_CAP) { atomicAdd(&(bar)[XB_TMO], 1u); break; } } } } while (0)

struct XcdBarrier {
    unsigned* bar; unsigned x;
    volatile LAS unsigned* st;
};

__device__ __forceinline__ XcdBarrier xcd_barrier_post(unsigned* bar, volatile LAS unsigned* st) {
    XcdBarrier b; b.bar = bar; b.x = xb_xcc_id(); b.st = st;
    if (threadIdx.x == 0) (void)xb_add(&bar[XB_XCNT(b.x)], 1u);
    return b;
}
__device__ __forceinline__ void xcd_barrier_complete(unsigned* bar, unsigned x, unsigned& nloc, unsigned& nx) {
    const unsigned G = gridDim.x * gridDim.y * gridDim.z;
    unsigned sum, cnt, mine, sp = 0u;
    for (;;) {
        sum = 0u; cnt = 0u; mine = 0u;
#pragma unroll
        for (unsigned j = 0; j < 16; ++j) { const unsigned c = xb_ld(&bar[XB_XCNT(j)]); sum += c; cnt += (c > 0u) ? 1u : 0u; mine = (j == x) ? c : mine; }
        if (sum == G) break;
        __builtin_amdgcn_s_sleep(1);
        if ((++sp & 255u) == 0u) { if (xb_ld(&bar[XB_TMO])) break; if (sp > XB_SPIN_CAP) { atomicAdd(&bar[XB_TMO], 1u); break; } }
    }
    nloc = mine > 0u ? mine : 1u; nx = cnt > 0u ? cnt : 1u;
}

__device__ __forceinline__ void xcd_barrier(const XcdBarrier& b) {
    asm volatile("s_waitcnt vmcnt(0)" ::: "memory");
    __syncthreads();
    if (threadIdx.x == 0) {
        unsigned* bar = b.bar;
        __builtin_amdgcn_s_waitcnt(0);
        unsigned nloc = b.st[0], nx = b.st[1];
        if (nloc == 0u) { xcd_barrier_complete(bar, b.x, nloc, nx); b.st[0] = nloc; b.st[1] = nx; }
        const unsigned old = xb_add(&bar[XB_XSUB(b.x)], 1u);
        const unsigned gen = old / nloc;
        if (old + 1u == (gen + 1u) * nloc) {
            __builtin_amdgcn_fence(__ATOMIC_RELEASE, "agent");
            asm volatile("s_waitcnt vmcnt(0)" ::: "memory");
            const unsigned og = xb_add(&bar[XB_TOP], 1u);
            const unsigned tg = og / nx;
            if (og + 1u == (tg + 1u) * nx) xb_add(&bar[XB_TOPGEN], 1u);
            else XB_SPIN(xb_ld(&bar[XB_TOPGEN]) == tg, bar);
            __builtin_amdgcn_fence(__ATOMIC_ACQUIRE, "agent");
            xb_add(&bar[XB_XGEN(b.x)], 1u);
            asm volatile("s_waitcnt vmcnt(0)" ::: "memory");
        } else {
            XB_SPIN(xb_ld(&bar[XB_XGEN(b.x)]) == gen, bar);
            __builtin_amdgcn_fence(__ATOMIC_ACQUIRE, "agent");
            asm volatile("s_waitcnt vmcnt(0)" ::: "memory");
        }
    }
    __syncthreads();
}

constexpr int NPHASES = 8;
__global__ void __launch_bounds__(512) mega(Params p) {
  extern __shared__ __attribute__((aligned(16))) unsigned char lds_raw[];
  LAS unsigned char* lds = (LAS unsigned char*)lds_raw;
  cg::grid_group grid = cg::this_grid();
  volatile LAS unsigned* xst = (volatile LAS unsigned*)(lds + 163840 - 16);
  unsigned* xbar = (unsigned*)(p.ws + WS_BAR);
  if (threadIdx.x == 0) { xst[0] = 0u; xst[1] = 0u; }
  __syncthreads();
  (void)xcd_barrier_post(xbar, xst);
#ifdef PROBE_SEL
  LAS unsigned long long* TS = (LAS unsigned long long*)(lds + 163840 - 128);
  const bool tsw = (blockIdx.x == 0 && threadIdx.x == 0);
  if (tsw) TS[0] = __builtin_amdgcn_s_memrealtime();
#endif
  for (int ph = p.ph_lo; ph < p.ph_hi; ++ph) {
#ifndef ONLYPH
#define ONLYPH -1
#endif
#define PHON(k) (ONLYPH == -1 || ONLYPH == (k))
    if (ph == 0) { if constexpr (PHON(0)) { phase0(p, lds);
#ifdef DOUBLE_PH0
      __syncthreads(); phase0(p, lds);
#endif
    } }
    else if (ph == 1) { if constexpr (PHON(1)) {
#ifdef PROBE_SEL
      if (tsw) TS[10] = __builtin_amdgcn_s_memtime();
#endif
      pg8::Gemm g{(const bf16*)(p.ws + WS_XB), (const bf16*)(p.ws + WS_WINT), NTOK, LDY, DM, DM, DM};
      pg8::BandOrder S; S.init(gridDim.x, BID(), 64);
      pg8::EpiBf16<0> E{(bf16*)(p.ws + WS_Y1), LDY, nullptr, 0, 0};
      pg8::gemm_phase<pg8::EpiBf16<0>, pg8::BandOrder, true, true>(lds, g, S, E);
#ifdef DOUBLE_PH1
      __syncthreads(); pg8::gemm_phase<pg8::EpiBf16<0>, pg8::BandOrder, true, true>(lds, g, S, E);
#endif
#ifdef PROBE_SEL
      if (tsw) TS[11] = __builtin_amdgcn_s_memtime();
#endif
    } } else if (ph == 2) { if constexpr (PHON(2)) { phase_mixers(p, lds);
#ifdef DOUBLE_PH2
      __syncthreads(); phase_mixers(p, lds);
#endif
    } }
    else if (ph == 3) { if constexpr (PHON(3)) phase_headnorm(p); }
    else if (ph == 4) { if constexpr (PHON(4)) {
      pg8::Gemm g{(const bf16*)(p.ws + WS_MIX), (const bf16*)(p.ws + WS_WBT), NTOK, DM, DM, DM, DM};
      pg8::TailSplitOrder S; S.init(gridDim.x, BID(), 64);
      EpiMerged E{(const bf16*)(p.ws + WS_Y1), (bf16*)(p.ws + WS_MRG), (float*)(p.ws + WS_P2)};
      pg8::gemm_phase<EpiMerged, pg8::TailSplitOrder, true, true>(lds, g, S, E);
    } } else if (ph == 5) { if constexpr (PHON(5)) phase_reduce2(p); }
    else if (ph == 6) { if constexpr (PHON(6)) {
      pg8::Gemm g{(const bf16*)(p.ws + WS_MRG), (const bf16*)(p.ws + WS_WOT), NTOK, DM, DM, DM, DM};
      pg8::TailSplitOrder S; S.init(gridDim.x, BID(), 64);
      EpiOut E{p.in[I_XP], p.in[I_XS], (bf16*)(p.ws + WS_Z), (float*)(p.ws + WS_P3)};
      pg8::gemm_phase<EpiOut, pg8::TailSplitOrder, true, true>(lds, g, S, E);
    } } else { if constexpr (PHON(7)) phase_ln(p); }
#ifdef PROBE_SEL
    grid.sync();
    if (tsw) TS[ph + 1] = __builtin_amdgcn_s_memrealtime();
#else
    if (ph + 1 < p.ph_hi) {
      if (p.ph_lo < 0) grid.sync();
      XcdBarrier xb; xb.bar = xbar; xb.x = xb_xcc_id(); xb.st = xst;
      xcd_barrier(xb);
    }
#endif
  }
#ifdef PROBE_SEL
  if (blockIdx.x == 0) { __syncthreads();
    const float tot = (float)(TS[8] - TS[0]);
    float a, b;
    if (PROBE_SEL == 1) { a = (float)(TS[1] - TS[0]); b = (float)(TS[2] - TS[1]); }
    else if (PROBE_SEL == 2) { a = (float)(TS[9] - TS[2]); b = (float)(TS[3] - TS[9]); }
    else if (PROBE_SEL == 3) { a = (float)(TS[6] - TS[4]); b = (float)(TS[7] - TS[6]); }
    else { a = (float)(TS[4] - TS[3]); b = (float)(TS[8] - TS[7]); }
    int qa = (int)(a / tot * 300.f), qb = (int)(b / tot * 300.f);
    if (PROBE_SEL == 6) { qa = (int)((float)(TS[2] - TS[1]) / 1000.f); qb = (int)((float)(TS[3] - TS[2]) / 1000.f); qa = qa > 299 ? 299 : qa; qb = qb > 299 ? 299 : qb; }
    if (PROBE_SEL == 5) { const float cyc = (float)(TS[11] - TS[10]), rt = (float)(TS[2] - TS[1]); qa = (int)(cyc / 832.f / 20.f); qb = (int)(cyc / rt * 10.f); } qa = qa > 299 ? 299 : qa; qb = qb > 299 ? 299 : qb;
    const float f = (float)(qa * 300 + qb) / 90000.f, eps = 0.01f * (1.f + f);
    for (int i = threadIdx.x; i < 1024; i += 512) p.out[O_SM + i] *= (1.f + eps);
  }
#endif
}
#ifndef N_LAUNCH_PER_PHASE
#define N_LAUNCH_PER_PHASE 0
#endif
extern "C" void kernel_launch(void* const* d_in, const int* in_sizes, int n_in, void* d_out, int out_size, void* d_ws, size_t ws_size, hipStream_t stream) {
  constexpr int LDSB = 160 * 1024;
  static int grid = 0;
  if (!grid) {
    int dev = 0, cus = 0;
    if (n_in != 16 || ws_size < WS_END || out_size != 124527648) { fprintf(stderr, "kernel_launch: unexpected sizes n_in %d ws %zu (need %zu) out %d\n", n_in, ws_size, (size_t)WS_END, out_size); grid = -1; return; }
    (void)hipGetDevice(&dev);
    (void)hipDeviceGetAttribute(&cus, hipDeviceAttributeMultiprocessorCount, dev);
    (void)hipFuncSetAttribute((const void*)mega, hipFuncAttributeMaxDynamicSharedMemorySize, LDSB);
    grid = cus;
  }
  if (grid < 0) return;
  (void)hipMemsetAsync((char*)d_ws + WS_BAR, 0, XCD_BAR_WORDS * 4, stream);
  Params p{};
  for (int i = 0; i < 16; ++i) p.in[i] = (const float*)d_in[i];
  p.out = (float*)d_out; p.ws = (unsigned char*)d_ws;
#if N_LAUNCH_PER_PHASE
  for (int ph = 0; ph < NPHASES; ++ph) { p.ph_lo = ph; p.ph_hi = ph + 1; hipLaunchKernelGGL(mega, dim3(grid), dim3(512), LDSB, stream, p); }
#else
  p.ph_lo = 0; p.ph_hi = NPHASES;
  void* args[] = {&p};
  hipError_t e = hipLaunchCooperativeKernel((const void*)mega, dim3(grid), dim3(512), args, LDSB, stream);
  if (e != hipSuccess) fprintf(stderr, "cooperative launch failed: %s (grid %d)\n", hipGetErrorString(e), grid);
#endif
}
```

```cpp
#include <hip/hip_runtime.h>
#include <hip/hip_cooperative_groups.h>
#include <cstdio>
#include <cstdint>
namespace cg = cooperative_groups;
static __device__ __forceinline__ int TID() { int t = threadIdx.x; asm volatile("" : "+v"(t)); return t; }
static __device__ __forceinline__ int BID() { int t = blockIdx.x; asm volatile("" : "+s"(t)); return t; }
namespace pg8 {
#define PG8_LAS __attribute__((address_space(3)))
typedef unsigned short bf16_t;
typedef short bf16x8 __attribute__((ext_vector_type(8)));
typedef float f32x4 __attribute__((ext_vector_type(4)));
typedef unsigned u32x4 __attribute__((ext_vector_type(4)));
constexpr int BM = 256, BK = 64, HALF = 128, HTB = HALF * BK * 2  , STAGE_BYTES = 8 * HTB, NXCD = 8, WGM = 8;

__host__ __device__ __forceinline__ int lds_byte(int r, int c) { const int st = (r >> 4) * 2 + (c >> 5), rr = r & 15, cc = c & 31, ob = rr * 64 + cc * 2; return st * 1024 + (ob ^ (((ob >> 9) & 1) << 5)); }
__host__ __device__ __forceinline__ void stage_rc(int b, int& R, int& C) { const int st = b / 1024, sb = b % 1024, swz = sb ^ (((sb >> 9) & 1) << 5); R = (st >> 1) * 16 + swz / 64; C = (st & 1) * 32 + (swz % 64) / 2; }
__host__ __device__ __forceinline__ int perm32(int rho) { const int n = rho >> 4, i = rho & 15; return 8 * (i >> 2) + 4 * n + (i & 3); }

struct Unit { int pm, pn, k0, nk, kind; };
struct Gemm { const bf16_t* A; const bf16_t* Bt; int M, N, K, lda, ldb; };

struct StaticOrder {
    int nM, nN, nwg, G, c, nk;
    __host__ __device__ void init(int M, int N, int G_, int c_, int nk_) { nM = M / BM; nN = N / BM; nwg = nM * nN; G = G_; c = c_; nk = nk_; }
    __host__ __device__ bool next(int i, Unit& u) const {
        const long L = (long)i * G + c; if (L >= nwg) return false;
        int wgid = (int)L; { const int q = nwg / NXCD, r = nwg % NXCD, xcd = wgid % NXCD, off = wgid / NXCD; wgid = (xcd < r ? xcd * (q + 1) : r * (q + 1) + (xcd - r) * q) + off; }
        const int nig = WGM * nN, gid = wgid / nig, fm = gid * WGM, gsz = (nM - fm) < WGM ? (nM - fm) : WGM;
        u.pm = fm + ((wgid % nig) % gsz); u.pn = (wgid % nig) / gsz; u.k0 = 0; u.nk = nk; u.kind = 0; return true;
    }
    __device__ __forceinline__ void a_ready(const Unit&) const {}
    __device__ __forceinline__ void done(const Unit&) const {}
};

struct TailSplitOrder {
    int G, c, nk;
    __host__ __device__ void init(int G_, int c_, int nk_) { G = G_; c = c_; nk = nk_; }
    __host__ __device__ bool next(int i, Unit& u) const {
        const long L = (long)i * G + c; if (L >= 768) return false;
        const bool full = L < 512;
        const int ii = (int)L >> 8, cc = (int)L & 255, x = cc & 7, j = cc >> 3, w = ii * 32 + j;
        const int s = (int)L - 512, un = s >> 2, kq = s & 3;
        u.pm = full ? 4 * x + (w & 3) : 32 + (un >> 4); u.pn = full ? (w >> 2) : (un & 15); u.k0 = full ? 0 : kq * (nk >> 2); u.nk = full ? nk : (nk >> 2); u.kind = full ? 0 : 1;
        return true;
    }
    __device__ __forceinline__ void a_ready(const Unit&) const {}
    __device__ __forceinline__ void done(const Unit&) const {}
};

struct BandOrder {
    int G, c, nk;
    __host__ __device__ void init(int G_, int c_, int nk_) { G = G_; c = c_; nk = nk_; }
    __host__ __device__ bool next(int i, Unit& u) const {
        const long L = (long)i * G + c; const int x = (int)(L & 7), l = (int)(L >> 3);
        if (l >= 414) return false;
        u.pm = 9 * (x & 3) + (l % 9); u.pn = 46 * (x >> 2) + (l / 9); u.k0 = 0; u.nk = nk; u.kind = 0; return true;
    }
    __device__ __forceinline__ void a_ready(const Unit&) const {}
    __device__ __forceinline__ void done(const Unit&) const {}
};
__device__ __forceinline__ unsigned cvt_pk_bf16(float lo, float hi) { unsigned r; asm volatile("v_cvt_pk_bf16_f32 %0, %1, %2" : "=v"(r) : "v"(lo), "v"(hi)); return r; }
typedef float f32x2 __attribute__((ext_vector_type(2)));
template <int ACT> struct EpiBf16 {
    static constexpr bool PERM = true, AFTER_DRAIN = false, HAS_MID = false; static constexpr int MID_T = 0;
    bf16_t* O; int ldc; const float* bias; int split_cols; size_t split_stride;
    __device__ __forceinline__ void operator()(const f32x4 (&acc)[2][2][4][2], const Unit& u, int wr, int wc, int fr, int fq) const {
        const int row0 = u.pm * BM + wr * 64 + fr, col0 = u.pn * BM + wc * 32 + 8 * fq;
#pragma unroll
        for (int ai = 0; ai < 2; ++ai)
#pragma unroll
            for (int m = 0; m < 4; ++m) { bf16_t* rowp = O + (size_t)(row0 + ai * HALF + m * 16) * ldc + col0;
#pragma unroll
                for (int bj = 0; bj < 2; ++bj) { const f32x4 v0 = acc[ai][bj][m][0], v1 = acc[ai][bj][m][1];
                    u32x4 w; w.x = cvt_pk_bf16(v0[0], v0[1]); w.y = cvt_pk_bf16(v0[2], v0[3]); w.z = cvt_pk_bf16(v1[0], v1[1]); w.w = cvt_pk_bf16(v1[2], v1[3]);
                    *(u32x4*)(rowp + bj * HALF) = w; } }
    }
};
template <class Epi, class Sched, bool ALIGN_EPI = false, bool SP2 = false>
__device__ __forceinline__ void gemm_phase(PG8_LAS unsigned char* lds, const Gemm g, const Sched& S, const Epi& E) {
    const int tid = TID(), wid = __builtin_amdgcn_readfirstlane(tid >> 6), lane = tid & 63, wr = wid >> 2, wc = wid & 3, fr = lane & 15, fq = lane >> 4;
    unsigned voffA[2], voffB[2];
#pragma unroll
    for (int i = 0; i < 2; ++i) { int R, C; stage_rc(tid * 16 + i * 8192, R, C); const int Rb = Epi::PERM ? ((R & ~31) + perm32(R & 31)) : R;
        voffA[i] = (unsigned)(R * g.lda + C) * 2u; voffB[i] = (unsigned)(Rb * g.ldb + C) * 2u; }
    const size_t kstep = (size_t)(BK * 2);
    const size_t hstepA = (size_t)HALF * g.lda * 2, hstepB = (size_t)HALF * g.ldb * 2;
    const size_t tstepA = 2 * hstepA, tstepB = 2 * hstepB;
    const unsigned ldsw = (unsigned)wid * 1024u;
    const int aoff = lds_byte(wr * 64 + fr, fq * 8), boff = lds_byte(wc * 32 + fr, fq * 8);
#define PG8_SA(b, h) (((b) * 2 + (h)) * HTB)
#define PG8_SB(b, h) ((4 + (b) * 2 + (h)) * HTB)
#define PG8_STAGE(bufoff, gbase, voff) do { _Pragma("unroll") for (int _i = 0; _i < 2; ++_i) \
        __builtin_amdgcn_global_load_lds((const unsigned*)((const char*)(gbase) + (voff)[_i]), (PG8_LAS unsigned*)(lds + (bufoff) + ldsw + _i * 8192), 16, 0, 0); } while (0)
#define PG8_LDA(dst, b, h) do { _Pragma("unroll") for (int m = 0; m < 4; ++m) _Pragma("unroll") for (int k = 0; k < 2; ++k) dst[m][k] = *(const PG8_LAS bf16x8*)(lds + PG8_SA(b, h) + aoff + m * 2048 + k * 1024); } while (0)
#define PG8_LDB(dst, b, h) do { _Pragma("unroll") for (int n = 0; n < 2; ++n) _Pragma("unroll") for (int k = 0; k < 2; ++k) dst[n][k] = *(const PG8_LAS bf16x8*)(lds + PG8_SB(b, h) + boff + n * 2048 + k * 1024); } while (0)
#define PG8_MMA(ai, bj, At, Bt) do { __builtin_amdgcn_s_setprio(1); _Pragma("unroll") for (int m = 0; m < 4; ++m) _Pragma("unroll") for (int n = 0; n < 2; ++n) _Pragma("unroll") for (int k = 0; k < 2; ++k) \
        acc[ai][bj][m][n] = __builtin_amdgcn_mfma_f32_16x16x32_bf16(Bt[n][k], At[m][k], acc[ai][bj][m][n], 0, 0, 0); __builtin_amdgcn_s_setprio(0); } while (0)
#define PG8_WAIT_V(n) asm volatile("s_waitcnt vmcnt(" #n ")" ::: "memory")
#define PG8_WAIT_L(n) asm volatile("s_waitcnt lgkmcnt(" #n ")" ::: "memory")
#define PG8_BAR __builtin_amdgcn_s_barrier()
#define PG8_SCHED __builtin_amdgcn_sched_barrier(0)
    Unit cur, nxt; int ui = 0;
    if (!S.next(0, cur)) return;
    f32x4 acc[2][2][4][2];
#pragma unroll
    for (int a = 0; a < 2; ++a)
#pragma unroll
        for (int b = 0; b < 2; ++b)
#pragma unroll
            for (int m = 0; m < 4; ++m)
#pragma unroll
                for (int n = 0; n < 2; ++n) acc[a][b][m][n] = (f32x4){0.f, 0.f, 0.f, 0.f};
    bf16x8 At[4][2], B0[2][2], B1[2][2];
    const char* cA = (const char*)g.A + (size_t)cur.pm * tstepA + (size_t)cur.k0 * kstep; const char* cB = (const char*)g.Bt + (size_t)cur.pn * tstepB + (size_t)cur.k0 * kstep;
    S.a_ready(cur);
    if constexpr (SP2) {
        PG8_STAGE(PG8_SB(0, 0), cB, voffB); PG8_STAGE(PG8_SB(0, 1), cB + hstepB, voffB); PG8_STAGE(PG8_SA(0, 0), cA, voffA); PG8_STAGE(PG8_SA(0, 1), cA + hstepA, voffA);
        if (wr == 1) PG8_BAR;
        PG8_WAIT_V(2); PG8_BAR;
        PG8_STAGE(PG8_SB(1, 0), cB + kstep, voffB); PG8_STAGE(PG8_SA(1, 0), cA + kstep, voffA); PG8_STAGE(PG8_SB(1, 1), cB + hstepB + kstep, voffB);
        PG8_WAIT_V(6); PG8_BAR;
    } else {
        PG8_STAGE(PG8_SB(0, 0), cB, voffB); PG8_STAGE(PG8_SA(0, 0), cA, voffA); PG8_STAGE(PG8_SB(0, 1), cB + hstepB, voffB); PG8_STAGE(PG8_SA(0, 1), cA + hstepA, voffA);
        if (wr == 1) PG8_BAR;
        PG8_WAIT_V(4); PG8_BAR;
        PG8_STAGE(PG8_SB(1, 0), cB + kstep, voffB); PG8_STAGE(PG8_SA(1, 0), cA + kstep, voffA); PG8_STAGE(PG8_SB(1, 1), cB + hstepB + kstep, voffB);
        PG8_WAIT_V(6); PG8_BAR;
    }
    for (;;) {
        const bool has_next = S.next(ui + 1, nxt);
        const char* nA = has_next ? (const char*)g.A + (size_t)nxt.pm * tstepA + (size_t)nxt.k0 * kstep : cA; const char* nB = has_next ? (const char*)g.Bt + (size_t)nxt.pn * tstepB + (size_t)nxt.k0 * kstep : cB;
        const int nt = cur.nk;
        for (int t = 0; t < nt; t += 2) {
            const bool last = (t == nt - 2);
            if constexpr (Epi::HAS_MID) { if (t == Epi::MID_T && cur.kind == 0) E.mid(acc, cur, wr, wc, fr, fq); }
            const char* a1 = cA + (size_t)(t + 1) * kstep;
            const char* a2 = last ? nA : cA + (size_t)(t + 2) * kstep; const char* b2 = last ? nB : cB + (size_t)(t + 2) * kstep;
            const char* a3 = a2 + kstep; const char* b3 = b2 + kstep;
            if (last && has_next) S.a_ready(nxt);
            if constexpr (SP2) {
            PG8_LDB(B0, 0, 0); PG8_LDB(B1, 0, 1); PG8_SCHED; PG8_LDA(At, 0, 0); PG8_STAGE(PG8_SA(1, 1), a1 + hstepA, voffA);
            PG8_WAIT_V(8); PG8_WAIT_L(0); PG8_BAR; PG8_MMA(0, 0, At, B0); PG8_MMA(0, 1, At, B1); PG8_BAR; PG8_SCHED;
            PG8_LDA(At, 0, 1); PG8_STAGE(PG8_SB(0, 0), b2, voffB); PG8_STAGE(PG8_SB(0, 1), b2 + hstepB, voffB); PG8_STAGE(PG8_SA(0, 0), a2, voffA);
            PG8_WAIT_V(8); PG8_WAIT_L(0); PG8_BAR; PG8_MMA(1, 0, At, B0); PG8_MMA(1, 1, At, B1); PG8_BAR; PG8_SCHED;
            PG8_LDB(B0, 1, 0); PG8_LDB(B1, 1, 1); PG8_SCHED; PG8_LDA(At, 1, 0); PG8_STAGE(PG8_SA(0, 1), a2 + hstepA, voffA);
            PG8_WAIT_V(8); PG8_WAIT_L(0); PG8_BAR; PG8_MMA(0, 0, At, B0); PG8_MMA(0, 1, At, B1); PG8_BAR; PG8_SCHED;
            PG8_LDA(At, 1, 1); PG8_STAGE(PG8_SB(1, 0), b3, voffB); PG8_STAGE(PG8_SB(1, 1), b3 + hstepB, voffB); PG8_STAGE(PG8_SA(1, 0), a3, voffA);
            PG8_WAIT_V(8); PG8_WAIT_L(0); PG8_BAR; PG8_MMA(1, 0, At, B0); PG8_MMA(1, 1, At, B1); PG8_BAR; PG8_SCHED;
            } else {
            PG8_LDB(B0, 0, 0); PG8_SCHED; PG8_LDA(At, 0, 0); PG8_STAGE(PG8_SA(1, 1), a1 + hstepA, voffA);
            PG8_WAIT_L(8); PG8_BAR; PG8_WAIT_L(0); PG8_MMA(0, 0, At, B0); PG8_BAR; PG8_SCHED;
            PG8_LDB(B1, 0, 1); PG8_STAGE(PG8_SB(0, 0), b2, voffB);
            PG8_BAR; PG8_WAIT_L(0); PG8_MMA(0, 1, At, B1); PG8_BAR;
            PG8_LDA(At, 0, 1); PG8_STAGE(PG8_SA(0, 0), a2, voffA);
            PG8_BAR; PG8_WAIT_L(0); PG8_MMA(1, 0, At, B0); PG8_BAR; PG8_SCHED;
            PG8_STAGE(PG8_SB(0, 1), b2 + hstepB, voffB);
            PG8_WAIT_V(6); PG8_BAR; PG8_MMA(1, 1, At, B1); PG8_BAR;
            PG8_LDB(B0, 1, 0); PG8_SCHED; PG8_LDA(At, 1, 0); PG8_STAGE(PG8_SA(0, 1), a2 + hstepA, voffA);
            PG8_WAIT_L(8); PG8_BAR; PG8_WAIT_L(0); PG8_MMA(0, 0, At, B0); PG8_BAR; PG8_SCHED;
            PG8_LDB(B1, 1, 1); PG8_STAGE(PG8_SB(1, 0), b3, voffB);
            PG8_BAR; PG8_WAIT_L(0); PG8_MMA(0, 1, At, B1); PG8_BAR;
            PG8_LDA(At, 1, 1); PG8_STAGE(PG8_SA(1, 0), a3, voffA);
            PG8_BAR; PG8_WAIT_L(0); PG8_MMA(1, 0, At, B0); PG8_BAR; PG8_SCHED;
            PG8_STAGE(PG8_SB(1, 1), b3 + hstepB, voffB);
            PG8_WAIT_V(6); PG8_BAR; PG8_MMA(1, 1, At, B1); PG8_BAR;
            }
        }
        if constexpr (ALIGN_EPI) { if (wr == 0) PG8_BAR; }
        if constexpr (!Epi::AFTER_DRAIN) { E(acc, cur, wr, wc, fr, fq); S.done(cur); }
        if (!has_next) break;
#pragma unroll
        for (int a = 0; a < 2; ++a)
#pragma unroll
            for (int b = 0; b < 2; ++b)
#pragma unroll
                for (int m = 0; m < 4; ++m)
#pragma unroll
                    for (int n = 0; n < 2; ++n) acc[a][b][m][n] = (f32x4){0.f, 0.f, 0.f, 0.f};
        cur = nxt; cA = nA; cB = nB; ++ui;
        if constexpr (ALIGN_EPI) { if (wr == 1) PG8_BAR; }
    }
    PG8_WAIT_V(0);
    if constexpr (!ALIGN_EPI) { if (wr == 0) PG8_BAR; }
    PG8_BAR;
    if constexpr (Epi::AFTER_DRAIN) { E.fused(acc, cur, wr, wc, fr, fq, lds, wid, lane); S.done(cur); }
#undef PG8_SA
#undef PG8_SB
#undef PG8_STAGE
#undef PG8_LDA
#undef PG8_LDB
#undef PG8_MMA
#undef PG8_WAIT_V
#undef PG8_WAIT_L
#undef PG8_BAR
#undef PG8_SCHED
}
}
#define LAS __attribute__((address_space(3)))
#define DI __device__ __forceinline__
typedef unsigned short bf16;
typedef short bf16x8 __attribute__((ext_vector_type(8)));
typedef float f32x4 __attribute__((ext_vector_type(4)));
typedef float f32x2 __attribute__((ext_vector_type(2)));
typedef unsigned u32x4 __attribute__((ext_vector_type(4)));
typedef unsigned u32x2 __attribute__((ext_vector_type(2)));

constexpr int DM = 4096, NTOK = 9216, NPR = 8192, SEQ = 2048;
constexpr int LDY = 23552;
constexpr int C_QM = 0, C_KM = 2048, C_VM = 4096, C_OM = 6144, C_ZM = 8192, C_QA = 10240, C_KA = 12288, C_VA = 12800, C_ZA = 13312, C_GM = 15360, C_GA = 19456;
constexpr int LDW = 23568;
constexpr int NROPE = 2056;
constexpr size_t O_YP = 0, O_YS = 33554432, O_PC = 37748736, O_PN = 39845888, O_PM = 39854080, O_PK = 39854112, O_PV = 40116256,
                 O_SC = 40378400, O_SN = 107487264, O_SM = 107749408, O_SK = 107750432, O_SV = 116139040;
constexpr size_t WS_XB = 0;
constexpr size_t WS_WINT = WS_XB + (size_t)NTOK * DM * 2;
constexpr size_t WS_WBT = WS_WINT + (size_t)LDY * DM * 2;
constexpr size_t WS_WOT = WS_WBT + (size_t)DM * DM * 2;
constexpr size_t WS_Y1 = WS_WOT + (size_t)DM * DM * 2;
constexpr size_t WS_G4 = WS_Y1 + (size_t)NTOK * LDY * 2;
constexpr size_t WS_ROPE = WS_G4 + (size_t)4 * NTOK * 16 * 4;
constexpr size_t WS_HB = WS_ROPE + (size_t)NROPE * 64 * 4;
constexpr size_t WS_MIX = WS_HB + (size_t)NTOK * 2048 * 2;
constexpr size_t WS_T = WS_MIX + (size_t)NTOK * DM * 2;
constexpr size_t WS_P2 = WS_T, WS_P3 = WS_T + (size_t)4 * 1024 * DM * 4;
constexpr size_t WS_MRG = WS_T + (size_t)NTOK * DM * 4;
constexpr size_t WS_Z = WS_MRG + (size_t)NTOK * DM * 2;
constexpr size_t WS_BAR = WS_Z + (size_t)NTOK * DM * 2;
constexpr size_t WS_END = WS_BAR + 16384;

struct Params { const float* in[16]; float* out; unsigned char* ws; int ph_lo, ph_hi; };
enum { I_XP = 0, I_XS, I_SC, I_SN, I_SM, I_CK, I_CV, I_WIN, I_BIF, I_NMG, I_SINK, I_WBM, I_WBA, I_WOUT, I_LNG, I_LNB };

DI float bf2f(unsigned b) { return __uint_as_float(b << 16); }
DI float bflo(unsigned w) { return __uint_as_float(w << 16); }
DI float bfhi(unsigned w) { return __uint_as_float(w & 0xffff0000u); }
DI unsigned pk2(float lo, float hi) { return pg8::cvt_pk_bf16(lo, hi); }
DI bf16 f2bf(float f) { return (bf16)(pk2(f, 0.f) & 0xffffu); }
DI float rcpf_(float x) { return __builtin_amdgcn_rcpf(x); }
DI float sigm(float x) { return __builtin_amdgcn_rcpf(1.f + __expf(-x)); }
DI float wave_sum(float v) {
#pragma unroll
  for (int o = 1; o < 64; o <<= 1) v += __shfl_xor(v, o);
  return v;
}
#define LDS_FENCE() asm volatile("s_waitcnt lgkmcnt(0)" ::: "memory")
#define MFMA16(a, b, c) __builtin_amdgcn_mfma_f32_16x16x32_bf16((a), (b), (c), 0, 0, 0)

DI void tr_item(const float* __restrict__ W, int ldw, int k0, int n0, bf16* __restrict__ WT, int ldt, int trow0, int tcol0, LAS unsigned* scr, int lane) {
  const int l16 = lane & 15, kq = lane >> 4;
  f32x4 v[16];
#pragma unroll
  for (int i = 0; i < 8; ++i) {
    const int k = 8 * i + 2 * kq;
    v[2 * i] = *(const f32x4*)(W + (size_t)(k0 + k) * ldw + n0 + l16 * 4);
    v[2 * i + 1] = *(const f32x4*)(W + (size_t)(k0 + k + 1) * ldw + n0 + l16 * 4);
  }
#pragma unroll
  for (int i = 0; i < 8; ++i) {
    const int kp = 4 * i + kq;
#pragma unroll
    for (int j = 0; j < 4; ++j) scr[(l16 * 4 + j) * 33 + kp] = pk2(v[2 * i][j], v[2 * i + 1][j]);
  }
  LDS_FENCE();
#pragma unroll
  for (int u = 0; u < 8; ++u) {
    const int n = u * 8 + (lane >> 3), kc = lane & 7;
    u32x4 o; o.x = scr[n * 33 + kc * 4]; o.y = scr[n * 33 + kc * 4 + 1]; o.z = scr[n * 33 + kc * 4 + 2]; o.w = scr[n * 33 + kc * 4 + 3];
    *(u32x4*)(WT + (size_t)(trow0 + n) * ldt + tcol0 + kc * 8) = o;
  }
  LDS_FENCE();
}
DI void xcvt_item(const Params& p, int item, int lane) {
  const int rg = item >> 2, kq4 = item & 3, r = lane & 15, q = lane >> 4;
  const int row = rg * 16 + r;
  const float* xr = row < NPR ? p.in[I_XP] + (size_t)row * DM : p.in[I_XS] + (size_t)(row - NPR) * DM;
  const float* wif = p.in[I_WIN] + 10240 + r;
  bf16* xb = (bf16*)(p.ws + WS_XB) + (size_t)row * DM;
  f32x4 acc = {0.f, 0.f, 0.f, 0.f};
#pragma unroll 2
  for (int k0 = kq4 * 1024; k0 < kq4 * 1024 + 1024; k0 += 64) {
    f32x4 xv[4]; float wv[4][4];
#pragma unroll
    for (int u = 0; u < 4; ++u) xv[u] = *(const f32x4*)(xr + k0 + 16 * u + 4 * q);
#pragma unroll
    for (int u = 0; u < 4; ++u)
#pragma unroll
      for (int i = 0; i < 4; ++i) wv[u][i] = wif[(size_t)(k0 + 16 * u + 4 * q + i) * LDW];
#pragma unroll
    for (int u = 0; u < 4; ++u) {
#pragma unroll
      for (int i = 0; i < 4; ++i) acc = __builtin_amdgcn_mfma_f32_16x16x4f32(xv[u][i], wv[u][i], acc, 0, 0, 0);
      u32x2 o; o.x = pk2(xv[u][0], xv[u][1]); o.y = pk2(xv[u][2], xv[u][3]);
      *(u32x2*)(xb + k0 + 16 * u + 4 * q) = o;
    }
  }
  float* g4 = (float*)(p.ws + WS_G4) + (size_t)kq4 * NTOK * 16;
#pragma unroll
  for (int j = 0; j < 4; ++j) g4[(size_t)(rg * 16 + 4 * q + j) * 16 + r] = acc[j];
}
DI void phase0(const Params& p, LAS unsigned char* lds) {
  const int tid = TID(), lane = tid & 63, wave = tid >> 6;
  const int gw = BID() * 8 + wave, NGW = gridDim.x * 8;
  LAS unsigned* scr = (LAS unsigned*)(lds + wave * 8704);
  {
    float* rt = (float*)(p.ws + WS_ROPE);
    for (int i = BID() * 512 + tid; i < NROPE * 32; i += gridDim.x * 512) {
      const int pi = i >> 5, fi = i & 31;
      const int pos = pi < SEQ ? pi : 8192 + (pi - SEQ);
      double inv = 1.0; const double rr = 0.74989420933245582730;
      for (int j = 0; j < fi; ++j) inv *= rr;
      double rev = (double)pos * inv * 0.15915494309189533577;
      rev -= floor(rev);
      const float rf = (float)rev;
      rt[pi * 64 + fi] = __builtin_amdgcn_cosf(rf);
      rt[pi * 64 + 32 + fi] = __builtin_amdgcn_sinf(rf);
    }
  }
  constexpr int N_X = (NTOK / 16) * 4;
  constexpr int N_WIN = 64 * (LDY / 64);
  constexpr int N_WB = 32 * 64, N_WO = 64 * 64;
  constexpr int NITEMS = N_X + N_WIN + 2 * N_WB + N_WO;
  for (int it = gw; it < NITEMS; it += NGW) {
    int r = it;
    if (r < N_X) { xcvt_item(p, r, lane); continue; } r -= N_X;
    if (r < N_WIN) { const int kt = r % 64, nt = r / 64; const int n0 = nt * 64;
      tr_item(p.in[I_WIN], LDW, kt * 64, n0 < 10240 ? n0 : n0 + 16, (bf16*)(p.ws + WS_WINT), DM, n0, kt * 64, scr, lane); continue; } r -= N_WIN;
    if (r < N_WB) { const int kt = r % 32, nt = r / 32; tr_item(p.in[I_WBM], DM, kt * 64, nt * 64, (bf16*)(p.ws + WS_WBT), DM, nt * 64, kt * 64, scr, lane); continue; } r -= N_WB;
    if (r < N_WB) { const int kt = r % 32, nt = r / 32; tr_item(p.in[I_WBA], DM, kt * 64, nt * 64, (bf16*)(p.ws + WS_WBT), DM, nt * 64, 2048 + kt * 64, scr, lane); continue; } r -= N_WB;
    { const int kt = r % 64, nt = r / 64; tr_item(p.in[I_WOUT], DM, kt * 64, nt * 64, (bf16*)(p.ws + WS_WOT), DM, nt * 64, kt * 64, scr, lane); }
  }
}
constexpr int MP_Q = 0, MP_K = 33792, MP_KT = 67584, MP_CT = 104448, MP_VT = 129792, MP_WVT = 136704, MP_S = 143616, MP_F = 152832;
DI void mlstm_prompt_item(const Params& p, LAS unsigned char* lds, int item) {
  const int tid = TID(), lane = tid & 63, w = __builtin_amdgcn_readfirstlane(tid >> 6), r = lane & 15, q = lane >> 4;
  const int sl = item & 7, h = (item >> 3) & 7, b = item >> 6;
  const bf16* Y1 = (const bf16*)(p.ws + WS_Y1);
  const float* G4 = (const float*)(p.ws + WS_G4);
  bf16* HB = (bf16*)(p.ws + WS_HB);
  LAS float* Fb = (LAS float*)(lds + MP_F);
  const float bi = p.in[I_BIF][h], bfg = p.in[I_BIF][8 + h];
  for (int i = tid; i < 48 * 264 / 2; i += 512) ((LAS unsigned*)(lds + MP_CT))[i] = 0u;
  for (int i = tid; i < 48 * 72 / 2; i += 512) { const int row = i / 36; ((LAS unsigned*)(lds + MP_VT))[i] = row == 32 ? 0x3f803f80u : 0u; ((LAS unsigned*)(lds + MP_WVT))[i] = 0u; }
  f32x4 st[2][3];
#pragma unroll
  for (int a = 0; a < 2; ++a)
#pragma unroll
    for (int e = 0; e < 3; ++e) st[a][e] = (f32x4){0.f, 0.f, 0.f, 0.f};
  float m_prev = 0.f;
  u32x4 pq[4], pk[4]; unsigned pkt[16]; unsigned pv[4]; float pgr[8] = {0.f, 0.f, 0.f, 0.f, 0.f, 0.f, 0.f, 0.f};
  const int dp = tid & 127, sg = tid >> 7;
  const int ve = tid & 31, vs = tid >> 5;
  auto issue = [&](int c) {
    const size_t row0 = (size_t)b * SEQ + (size_t)c * 64;
#pragma unroll
    for (int i = 0; i < 4; ++i) { const int id = tid + 512 * i, row = id >> 5, cc = id & 31;
      pq[i] = *(const u32x4*)(Y1 + (row0 + row) * LDY + C_QM + h * 256 + cc * 8);
      pk[i] = *(const u32x4*)(Y1 + (row0 + row) * LDY + C_KM + h * 256 + cc * 8); }
#pragma unroll
    for (int i = 0; i < 16; ++i) pkt[i] = *(const unsigned*)(Y1 + (row0 + sg * 16 + i) * LDY + C_KM + h * 256 + 2 * dp);
#pragma unroll
    for (int i = 0; i < 4; ++i) pv[i] = (unsigned)Y1[(row0 + vs * 4 + i) * LDY + C_VM + h * 256 + sl * 32 + ve];
    if (w == 7) {
#pragma unroll
      for (int k4 = 0; k4 < 4; ++k4) { pgr[k4] = G4[((size_t)k4 * NTOK + row0 + lane) * 16 + h]; pgr[4 + k4] = G4[((size_t)k4 * NTOK + row0 + lane) * 16 + 8 + h]; } }
  };
  auto commit = [&]() {
#pragma unroll
    for (int i = 0; i < 4; ++i) { const int id = tid + 512 * i, row = id >> 5, cc = id & 31;
      *(LAS u32x4*)(lds + MP_Q + row * 528 + cc * 16) = pq[i]; *(LAS u32x4*)(lds + MP_K + row * 528 + cc * 16) = pk[i]; }
    { u32x4 a0, a1, b0, b1;
      a0.x = (pkt[0] & 0xffffu) | (pkt[1] << 16); a0.y = (pkt[2] & 0xffffu) | (pkt[3] << 16); a0.z = (pkt[4] & 0xffffu) | (pkt[5] << 16); a0.w = (pkt[6] & 0xffffu) | (pkt[7] << 16);
      a1.x = (pkt[8] & 0xffffu) | (pkt[9] << 16); a1.y = (pkt[10] & 0xffffu) | (pkt[11] << 16); a1.z = (pkt[12] & 0xffffu) | (pkt[13] << 16); a1.w = (pkt[14] & 0xffffu) | (pkt[15] << 16);
      b0.x = (pkt[0] >> 16) | (pkt[1] & 0xffff0000u); b0.y = (pkt[2] >> 16) | (pkt[3] & 0xffff0000u); b0.z = (pkt[4] >> 16) | (pkt[5] & 0xffff0000u); b0.w = (pkt[6] >> 16) | (pkt[7] & 0xffff0000u);
      b1.x = (pkt[8] >> 16) | (pkt[9] & 0xffff0000u); b1.y = (pkt[10] >> 16) | (pkt[11] & 0xffff0000u); b1.z = (pkt[12] >> 16) | (pkt[13] & 0xffff0000u); b1.w = (pkt[14] >> 16) | (pkt[15] & 0xffff0000u);
      LAS unsigned char* kt0 = lds + MP_KT + (2 * dp) * 144 + sg * 32;
      *(LAS u32x4*)(kt0) = a0; *(LAS u32x4*)(kt0 + 16) = a1; *(LAS u32x4*)(kt0 + 144) = b0; *(LAS u32x4*)(kt0 + 160) = b1; }
    asm volatile("" : "+v"(pv[0]), "+v"(pv[1]), "+v"(pv[2]), "+v"(pv[3]));
    { u32x2 o; o.x = pv[0] | (pv[1] << 16); o.y = pv[2] | (pv[3] << 16);
      *(LAS u32x2*)(lds + MP_VT + ve * 144 + vs * 8) = o; }
  };
  float gi = 0.f, gf = 0.f;
  auto scan = [&](LAS float* F) {
    const float igv = gi + bi; const float xf = gf + bfg;
    const float lfv = fminf(xf, 0.f) - log1pf(__expf(-fabsf(xf)));
    float bc = lfv;
#pragma unroll
    for (int o = 1; o < 64; o <<= 1) { const float t = __shfl_up(bc, o); if (lane >= o) bc += t; }
    float pm = igv - bc;
#pragma unroll
    for (int o = 1; o < 64; o <<= 1) { const float t = __shfl_up(pm, o); if (lane >= o) pm = fmaxf(pm, t); }
    const float a = bc + m_prev, mt = fmaxf(a, bc + pm);
    const float m_new = __shfl(mt, 63), bl = __shfl(bc, 63);
    F[lane] = __expf(bc - mt); F[64 + lane] = __expf(igv - bc) * 0.0625f; F[128 + lane] = mt;     F[192 + lane] = __expf(a - mt); F[256 + lane] = __expf(bl - bc + igv - m_new) * 0.0625f;
    if (lane == 0) F[384] = __expf(bl + m_prev - m_new);
    m_prev = m_new;
  };
  issue(0);
  __syncthreads();
  commit();
  asm volatile("" : "+v"(pgr[0]), "+v"(pgr[1]), "+v"(pgr[2]), "+v"(pgr[3]), "+v"(pgr[4]), "+v"(pgr[5]), "+v"(pgr[6]), "+v"(pgr[7]));
  gi = (pgr[0] + pgr[1]) + (pgr[2] + pgr[3]); gf = (pgr[4] + pgr[5]) + (pgr[6] + pgr[7]);
  if (w == 7) scan(Fb);
  const int tt = w >> 1, stb = (w & 1) * 2;
  for (int c = 0; c < 32; ++c) {
    const size_t row0 = (size_t)b * SEQ + (size_t)c * 64;
    LAS float* F = Fb + (c & 1) * 400; LAS float* Fn = Fb + ((c + 1) & 1) * 400;
    if (c + 1 < 32) issue(c + 1);
    __syncthreads();
    bf16 og[2][4];
    if (w < 4) {
#pragma unroll
      for (int et = 0; et < 2; ++et)
#pragma unroll
        for (int j = 0; j < 4; ++j) og[et][j] = Y1[(row0 + w * 16 + 4 * q + j) * LDY + C_OM + h * 256 + sl * 32 + et * 16 + r];
    }
    f32x4 sa[2] = {(f32x4){0.f, 0.f, 0.f, 0.f}, (f32x4){0.f, 0.f, 0.f, 0.f}};
#pragma unroll
    for (int ks = 0; ks < 8; ++ks) {
      const bf16x8 af = *(const LAS bf16x8*)(lds + MP_Q + (tt * 16 + r) * 528 + ks * 64 + q * 16);
#pragma unroll
      for (int j = 0; j < 2; ++j) if (stb + j <= tt) {
        const bf16x8 bfr = *(const LAS bf16x8*)(lds + MP_K + ((stb + j) * 16 + r) * 528 + ks * 64 + q * 16);
        sa[j] = MFMA16(af, bfr, sa[j]); }
    }
#pragma unroll
    for (int j = 0; j < 2; ++j) {
      const int s = (stb + j) * 16 + r; const float cf = F[64 + s];
#pragma unroll
      for (int g = 0; g < 4; ++g) { const int t = tt * 16 + 4 * q + g;
        const float v = (s <= t) ? sa[j][g] * (F[t] * cf) : 0.f;
        *(LAS bf16*)(lds + MP_S + t * 144 + s * 2) = f2bf(v); }
    }
    {
      const u32x2 vv = *(const LAS u32x2*)(lds + MP_VT + ve * 144 + vs * 8);
      const float w0 = F[256 + vs * 4], w1 = F[256 + vs * 4 + 1], w2 = F[256 + vs * 4 + 2], w3 = F[256 + vs * 4 + 3];
      u32x2 o; o.x = pk2(bflo(vv.x) * w0, bfhi(vv.x) * w1); o.y = pk2(bflo(vv.y) * w2, bfhi(vv.y) * w3);
      *(LAS u32x2*)(lds + MP_WVT + ve * 144 + vs * 8) = o;
      if (tid < 64) *(LAS bf16*)(lds + MP_WVT + 32 * 144 + tid * 2) = f2bf(F[256 + tid]);
    }
    __syncthreads();
    f32x4 nS[2] = {(f32x4){0.f, 0.f, 0.f, 0.f}, (f32x4){0.f, 0.f, 0.f, 0.f}}, nC[2] = {(f32x4){0.f, 0.f, 0.f, 0.f}, (f32x4){0.f, 0.f, 0.f, 0.f}};
    const int t4 = w & 3, e0 = (w < 4) ? 0 : 2, ne = (w < 4) ? 2 : 1;
#pragma unroll
    for (int ks = 0; ks < 2; ++ks) {
      const bf16x8 af = *(const LAS bf16x8*)(lds + MP_S + (t4 * 16 + r) * 144 + ks * 64 + q * 16);
#pragma unroll
      for (int j = 0; j < 2; ++j) if (j < ne) { const bf16x8 bfr = *(const LAS bf16x8*)(lds + MP_VT + ((e0 + j) * 16 + r) * 144 + ks * 64 + q * 16); nS[j] = MFMA16(af, bfr, nS[j]); }
    }
#pragma unroll
    for (int ks = 0; ks < 8; ++ks) {
      const bf16x8 af = *(const LAS bf16x8*)(lds + MP_Q + (t4 * 16 + r) * 528 + ks * 64 + q * 16);
#pragma unroll
      for (int j = 0; j < 2; ++j) if (j < ne) { const bf16x8 bfr = *(const LAS bf16x8*)(lds + MP_CT + ((e0 + j) * 16 + r) * 528 + ks * 64 + q * 16); nC[j] = MFMA16(af, bfr, nC[j]); }
    }
    float num[2][4];
#pragma unroll
    for (int j = 0; j < 2; ++j)
#pragma unroll
      for (int g = 0; g < 4; ++g) num[j][g] = nS[j][g] + F[192 + t4 * 16 + 4 * q + g] * nC[j][g];
    if (w >= 4 && r == 0) {
#pragma unroll
      for (int g = 0; g < 4; ++g) F[320 + t4 * 16 + 4 * q + g] = num[0][g];
    }
    { const float dec = F[384];
#pragma unroll
      for (int a = 0; a < 2; ++a)
#pragma unroll
        for (int e = 0; e < 3; ++e) st[a][e] *= dec;
#pragma unroll
      for (int ks = 0; ks < 2; ++ks) {
        bf16x8 bw[3];
#pragma unroll
        for (int e = 0; e < 3; ++e) bw[e] = *(const LAS bf16x8*)(lds + MP_WVT + (e * 16 + r) * 144 + ks * 64 + q * 16);
#pragma unroll
        for (int a = 0; a < 2; ++a) { const bf16x8 af = *(const LAS bf16x8*)(lds + MP_KT + ((2 * w + a) * 16 + r) * 144 + ks * 64 + q * 16);
#pragma unroll
          for (int e = 0; e < 3; ++e) st[a][e] = MFMA16(af, bw[e], st[a][e]); }
      }
    }
    __syncthreads();
    if (w < 4) {
#pragma unroll
      for (int g = 0; g < 4; ++g) { const int t = t4 * 16 + 4 * q + g; const float dn = fmaxf(fabsf(F[320 + t]), __expf(-F[128 + t])), rd = rcpf_(dn);
#pragma unroll
        for (int j = 0; j < 2; ++j) HB[(row0 + t) * 2048 + h * 256 + sl * 32 + j * 16 + r] = f2bf(sigm(bf2f(og[j][g])) * num[j][g] * rd); }
    }
#pragma unroll
    for (int a = 0; a < 2; ++a)
#pragma unroll
      for (int e = 0; e < 3; ++e) { u32x2 o; o.x = pk2(st[a][e][0], st[a][e][1]); o.y = pk2(st[a][e][2], st[a][e][3]);
        *(LAS u32x2*)(lds + MP_CT + (e * 16 + r) * 528 + ((2 * w + a) * 16 + 4 * q) * 2) = o; }
    if (c + 1 < 32) { commit(); asm volatile("" : "+v"(pgr[0]), "+v"(pgr[1]), "+v"(pgr[2]), "+v"(pgr[3]), "+v"(pgr[4]), "+v"(pgr[5]), "+v"(pgr[6]), "+v"(pgr[7])); gi = (pgr[0] + pgr[1]) + (pgr[2] + pgr[3]); gf = (pgr[4] + pgr[5]) + (pgr[6] + pgr[7]); if (w == 7) scan(Fn); }
  }
  float* oC = p.out + O_PC + (size_t)(b * 8 + h) * 65536;
#pragma unroll
  for (int a = 0; a < 2; ++a)
#pragma unroll
    for (int g = 0; g < 4; ++g) { const int d = (2 * w + a) * 16 + 4 * q + g;
      oC[(size_t)d * 256 + sl * 32 + r] = st[a][0][g]; oC[(size_t)d * 256 + sl * 32 + 16 + r] = st[a][1][g];
      if (sl == 0 && r == 0) p.out[O_PN + (size_t)(b * 8 + h) * 256 + d] = st[a][2][g]; }
  if (sl == 0 && tid == 448) p.out[O_PM + b * 8 + h] = m_prev;
  __syncthreads();
}
DI void mlstm_sample_item(const Params& p, LAS unsigned char* lds, int item) {
  const int tid = TID(), lane = tid & 63, w = tid >> 6;
  const int h = item & 7, b = item >> 3;
  const bf16* Y1 = (const bf16*)(p.ws + WS_Y1);
  const float* G4 = (const float*)(p.ws + WS_G4);
  bf16* HB = (bf16*)(p.ws + WS_HB);
  LAS float* qs = (LAS float*)lds; LAS float* ks = (LAS float*)(lds + 8192); LAS float* vs = (LAS float*)(lds + 16384);
  LAS float* red = (LAS float*)(lds + 24576); LAS float* n0 = (LAS float*)(lds + 90112);
  LAS float* M = (LAS float*)(lds + 91136);
  const size_t row0 = (size_t)NPR + (size_t)b * 8;
  { const int t = tid >> 6, c4 = (tid & 63) * 4;
    const u32x2 a = *(const u32x2*)(Y1 + (row0 + t) * LDY + C_QM + h * 256 + c4);
    const u32x2 k2 = *(const u32x2*)(Y1 + (row0 + t) * LDY + C_KM + h * 256 + c4);
    const u32x2 v2 = *(const u32x2*)(Y1 + (row0 + t) * LDY + C_VM + h * 256 + c4);
    *(LAS f32x4*)(qs + t * 256 + c4) = (f32x4){bflo(a.x), bfhi(a.x), bflo(a.y), bfhi(a.y)};
    *(LAS f32x4*)(ks + t * 256 + c4) = (f32x4){bflo(k2.x) * 0.0625f, bfhi(k2.x) * 0.0625f, bflo(k2.y) * 0.0625f, bfhi(k2.y) * 0.0625f};
    *(LAS f32x4*)(vs + t * 256 + c4) = (f32x4){bflo(v2.x), bfhi(v2.x), bflo(v2.y), bfhi(v2.y)};
    if (tid < 256) n0[tid] = p.in[I_SN][(size_t)item * 256 + tid];
    if (tid < 8) { float si = 0.f, sf = 0.f;
      for (int k4 = 0; k4 < 4; ++k4) { si += G4[((size_t)k4 * NTOK + row0 + tid) * 16 + h]; sf += G4[((size_t)k4 * NTOK + row0 + tid) * 16 + 8 + h]; }
      const float xf = sf + p.in[I_BIF][8 + h];
      M[tid] = si + p.in[I_BIF][h]; M[8 + tid] = fminf(xf, 0.f) - log1pf(__expf(-fabsf(xf))); }
  }
  __syncthreads();
  if (tid < 8) {
    const float m0 = p.in[I_SM][item];
    float bc = 0.f, pm = -3.0e38f, bct = 0.f, pmt = 0.f;
#pragma unroll
    for (int s2 = 0; s2 < 8; ++s2) { bc += M[8 + s2]; pm = fmaxf(pm, M[s2] - bc); if (s2 == tid) { bct = bc; pmt = pm; } }
    const float a = bct + m0, mt = fmaxf(a, bct + pmt), m_new = fmaxf(bc + m0, bc + pm);
    M[128 + tid] = bct; M[16 + tid] = mt; M[24 + tid] = __expf(a - mt); M[32 + tid] = __expf(bc - bct + M[tid] - m_new);
    if (tid == 0) { M[40] = __expf(bc + m0 - m_new); M[41] = m_new; }
  }
  __syncthreads();
  {
    const int t = w; const f32x4 qv = *(const LAS f32x4*)(qs + t * 256 + lane * 4);
    float pr[9];
#pragma unroll
    for (int s2 = 0; s2 < 8; ++s2) { const f32x4 kv = *(const LAS f32x4*)(ks + s2 * 256 + lane * 4); pr[s2] = (qv[0] * kv[0] + qv[1] * kv[1]) + (qv[2] * kv[2] + qv[3] * kv[3]); }
    { const f32x4 nv = *(const LAS f32x4*)(n0 + lane * 4); pr[8] = (qv[0] * nv[0] + qv[1] * nv[1]) + (qv[2] * nv[2] + qv[3] * nv[3]); }
#pragma unroll
    for (int o = 1; o < 64; o <<= 1) {
#pragma unroll
      for (int s2 = 0; s2 < 9; ++s2) pr[s2] += __shfl_xor(pr[s2], o);
    }
    if (lane == 0) {
#pragma unroll
      for (int s2 = 0; s2 < 8; ++s2) M[64 + t * 8 + s2] = (s2 <= t) ? pr[s2] * __expf(M[128 + t] - M[128 + s2] + M[s2] - M[16 + t]) : 0.f;
      M[48 + t] = pr[8];
    }
  }
  const float decay = M[40];
  const int e4 = lane * 4;
  f32x4 wv[8], num[8];
#pragma unroll
  for (int s = 0; s < 8; ++s) { wv[s] = *(const LAS f32x4*)(vs + s * 256 + e4) * M[32 + s]; num[s] = (f32x4){0.f, 0.f, 0.f, 0.f}; }
  const float* C0 = p.in[I_SC] + (size_t)item * 65536;
  float* C1 = p.out + O_SC + (size_t)item * 65536;
#pragma unroll 1
  for (int i0 = 0; i0 < 32; i0 += 8) {
    f32x4 cb[8];
#pragma unroll
    for (int u = 0; u < 8; ++u) cb[u] = __builtin_nontemporal_load((const f32x4*)(C0 + (size_t)(w + 8 * (i0 + u)) * 256 + e4));
#pragma unroll
    for (int u = 0; u < 8; ++u) {
      const int d = w + 8 * (i0 + u);
      const f32x4 c4 = cb[u];
      f32x4 cn = c4 * decay;
#pragma unroll
      for (int t = 0; t < 8; ++t) { const float qd = qs[t * 256 + d], kd = ks[t * 256 + d]; num[t] += c4 * qd; cn += wv[t] * kd; }
      __builtin_nontemporal_store(cn, (f32x4*)(C1 + (size_t)d * 256 + e4));
    }
  }
#pragma unroll
  for (int t = 0; t < 8; ++t) *(LAS f32x4*)(red + (w * 8 + t) * 256 + e4) = num[t];
  __syncthreads();
  { const int t = w;
    f32x4 nc = {0.f, 0.f, 0.f, 0.f};
#pragma unroll
    for (int w2 = 0; w2 < 8; ++w2) nc += *(const LAS f32x4*)(red + (w2 * 8 + t) * 256 + e4);
    f32x4 sv = {0.f, 0.f, 0.f, 0.f}; float ss = 0.f;
#pragma unroll
    for (int s = 0; s < 8; ++s) { const float S = M[64 + t * 8 + s]; sv += *(const LAS f32x4*)(vs + s * 256 + e4) * S; ss += S; }
    const float inter = M[24 + t], den = ss + inter * M[48 + t], dn = fmaxf(fabsf(den), __expf(-M[16 + t])), rd = rcpf_(dn);
    const u32x2 o2 = *(const u32x2*)(Y1 + (row0 + t) * LDY + C_OM + h * 256 + e4);
    const f32x4 hv = (sv + nc * inter) * rd;
    u32x2 o; o.x = pk2(sigm(bflo(o2.x)) * hv[0], sigm(bfhi(o2.x)) * hv[1]); o.y = pk2(sigm(bflo(o2.y)) * hv[2], sigm(bfhi(o2.y)) * hv[3]);
    *(u32x2*)(HB + (row0 + t) * 2048 + h * 256 + e4) = o;
  }
  if (tid < 256) { float nn = decay * n0[tid];
#pragma unroll
    for (int s = 0; s < 8; ++s) nn += M[32 + s] * ks[s * 256 + tid];
    p.out[O_SN + (size_t)item * 256 + tid] = nn; }
  if (tid == 0) p.out[O_SM + item] = M[41];
  __syncthreads();
}

constexpr int AT_K = 0, AT_VT = 23040, AT_END = 23040 + 64 * 336;
DI void attn_wave(const LAS unsigned char* lds, bf16x8 qf0, bf16x8 qf1, int klo, int khi, float sink, f32x4 (&o)[4]) {
  const int lane = TID() & 63, r = lane & 15, q = lane >> 4;
  f32x4 s[10];
#pragma unroll
  for (int kt = 0; kt < 10; ++kt) {
    const bf16x8 a0 = *(const LAS bf16x8*)(lds + AT_K + (kt * 16 + r) * 144 + q * 16), a1 = *(const LAS bf16x8*)(lds + AT_K + (kt * 16 + r) * 144 + 64 + q * 16);
    f32x4 acc = {0.f, 0.f, 0.f, 0.f};
    acc = MFMA16(a0, qf0, acc); acc = MFMA16(a1, qf1, acc);
    s[kt] = acc;
  }
  float mx = sink;
#pragma unroll
  for (int kt = 0; kt < 10; ++kt)
#pragma unroll
    for (int g = 0; g < 4; ++g) { const int j = kt * 16 + 4 * q + g; const bool ok = (j >= klo) && (j <= khi); s[kt][g] = ok ? s[kt][g] * 0.125f : -3.0e38f; mx = fmaxf(mx, s[kt][g]); }
  mx = fmaxf(mx, __shfl_xor(mx, 16)); mx = fmaxf(mx, __shfl_xor(mx, 32));
  float sum = 0.f;
#pragma unroll
  for (int kt = 0; kt < 10; ++kt)
#pragma unroll
    for (int g = 0; g < 4; ++g) { const float pv = s[kt][g] > -1.0e38f ? __expf(s[kt][g] - mx) : 0.f; s[kt][g] = pv; sum += pv; }
  sum += __shfl_xor(sum, 16); sum += __shfl_xor(sum, 32);
  const float rden = rcpf_(sum + __expf(sink - mx));
#pragma unroll
  for (int dt = 0; dt < 4; ++dt) o[dt] = (f32x4){0.f, 0.f, 0.f, 0.f};
#pragma unroll
  for (int u = 0; u < 5; ++u) {
    u32x4 pw; pw.x = pk2(s[2 * u][0], s[2 * u][1]); pw.y = pk2(s[2 * u][2], s[2 * u][3]); pw.z = pk2(s[2 * u + 1][0], s[2 * u + 1][1]); pw.w = pk2(s[2 * u + 1][2], s[2 * u + 1][3]);
    const bf16x8 pb = __builtin_bit_cast(bf16x8, pw);
#pragma unroll
    for (int dt = 0; dt < 4; ++dt) {
      const u32x2 lo = *(const LAS u32x2*)(lds + AT_VT + (dt * 16 + r) * 336 + (u * 32 + 4 * q) * 2), hi = *(const LAS u32x2*)(lds + AT_VT + (dt * 16 + r) * 336 + (u * 32 + 16 + 4 * q) * 2);
      u32x4 aw; aw.x = lo.x; aw.y = lo.y; aw.z = hi.x; aw.w = hi.y;
      o[dt] = MFMA16(__builtin_bit_cast(bf16x8, aw), pb, o[dt]);
    }
  }
#pragma unroll
  for (int dt = 0; dt < 4; ++dt) o[dt] *= rden;
}
DI void rope8(const u32x4 x1, const u32x4 x2, const float* rt, int i0, float (&o1)[8], float (&o2)[8]) {
  const f32x4 c0 = *(const f32x4*)(rt + i0), c1 = *(const f32x4*)(rt + i0 + 4), s0 = *(const f32x4*)(rt + 32 + i0), s1 = *(const f32x4*)(rt + 32 + i0 + 4);
  const float a[8] = {bflo(x1.x), bfhi(x1.x), bflo(x1.y), bfhi(x1.y), bflo(x1.z), bfhi(x1.z), bflo(x1.w), bfhi(x1.w)};
  const float bb[8] = {bflo(x2.x), bfhi(x2.x), bflo(x2.y), bfhi(x2.y), bflo(x2.z), bfhi(x2.z), bflo(x2.w), bfhi(x2.w)};
  const float cs[8] = {c0[0], c0[1], c0[2], c0[3], c1[0], c1[1], c1[2], c1[3]}, sn[8] = {s0[0], s0[1], s0[2], s0[3], s1[0], s1[1], s1[2], s1[3]};
#pragma unroll
  for (int j = 0; j < 8; ++j) { o1[j] = a[j] * cs[j] - bb[j] * sn[j]; o2[j] = bb[j] * cs[j] + a[j] * sn[j]; }
}
DI void rope8r(const u32x4 x1, const u32x4 x2, const f32x4 (&t)[4], float (&o1)[8], float (&o2)[8]) {
  const float a[8] = {bflo(x1.x), bfhi(x1.x), bflo(x1.y), bfhi(x1.y), bflo(x1.z), bfhi(x1.z), bflo(x1.w), bfhi(x1.w)};
  const float bb[8] = {bflo(x2.x), bfhi(x2.x), bflo(x2.y), bfhi(x2.y), bflo(x2.z), bfhi(x2.z), bflo(x2.w), bfhi(x2.w)};
#pragma unroll
  for (int j = 0; j < 8; ++j) { const float c = t[j >> 2][j & 3], sn = t[2 + (j >> 2)][j & 3]; o1[j] = a[j] * c - bb[j] * sn; o2[j] = bb[j] * c + a[j] * sn; }
}
DI u32x4 pack8(const float (&v)[8]) { u32x4 o; o.x = pk2(v[0], v[1]); o.y = pk2(v[2], v[3]); o.z = pk2(v[4], v[5]); o.w = pk2(v[6], v[7]); return o; }
DI void attn_store(const Params& p, const f32x4 (&o)[4], size_t row, int head) {
  const int lane = TID() & 63, q = lane >> 4;
  const bf16* Y1 = (const bf16*)(p.ws + WS_Y1); bf16* MIX = (bf16*)(p.ws + WS_MIX);
#pragma unroll
  for (int dt = 0; dt < 4; ++dt) {
    const u32x2 z = *(const u32x2*)(Y1 + row * LDY + C_ZA + head * 64 + dt * 16 + 4 * q);
    const float z0 = bflo(z.x), z1 = bfhi(z.x), z2 = bflo(z.y), z3 = bfhi(z.y);
    u32x2 w; w.x = pk2(o[dt][0] * z0 * sigm(z0), o[dt][1] * z1 * sigm(z1)); w.y = pk2(o[dt][2] * z2 * sigm(z2), o[dt][3] * z3 * sigm(z3));
    *(u32x2*)(MIX + row * DM + 2048 + head * 64 + dt * 16 + 4 * q) = w;
  }
}
DI void attn_store_z(const Params& p, const f32x4 (&o)[4], const u32x2 (&zz)[4], size_t row, int head) {
  const int lane = TID() & 63, q = lane >> 4;
  bf16* MIX = (bf16*)(p.ws + WS_MIX);
#pragma unroll
  for (int dt = 0; dt < 4; ++dt) {
    const float z0 = bflo(zz[dt].x), z1 = bfhi(zz[dt].x), z2 = bflo(zz[dt].y), z3 = bfhi(zz[dt].y);
    u32x2 w; w.x = pk2(o[dt][0] * z0 * sigm(z0), o[dt][1] * z1 * sigm(z1)); w.y = pk2(o[dt][2] * z2 * sigm(z2), o[dt][3] * z3 * sigm(z3));
    *(u32x2*)(MIX + row * DM + 2048 + head * 64 + dt * 16 + 4 * q) = w;
  }
}
DI void attn_prompt_item(const Params& p, LAS unsigned char* lds, int item) {
  const int tid = TID(), lane = tid & 63, w = tid >> 6, r = lane & 15, q = lane >> 4;
  const int kvh = item & 7, qb = (item >> 3) & 63, b = item >> 9, q0 = qb * 32;
  const bf16* Y1 = (const bf16*)(p.ws + WS_Y1); const float* RT = (const float*)(p.ws + WS_ROPE);
  const size_t rowb = (size_t)b * SEQ;
  const int g = w >> 1, qt = w & 1, head = kvh * 4 + g, qpos = q0 + qt * 16 + r;
  u32x4 kx1[2], kx2[2]; f32x4 kc[2][4]; unsigned vv[2][8]; u32x4 qx1, qx2; f32x4 qc[4]; u32x2 zz[4];
#pragma unroll
  for (int t = 0; t < 2; ++t) {
    const int task = tid + 512 * t, j = task >> 2, c4 = task & 3, pos = q0 - 128 + j;
    kx1[t] = (u32x4){0u, 0u, 0u, 0u}; kx2[t] = kx1[t];
#pragma unroll
    for (int i = 0; i < 4; ++i) kc[t][i] = (f32x4){0.f, 0.f, 0.f, 0.f};
    if (task < 640 && pos >= 0) { const bf16* src = Y1 + (rowb + pos) * LDY + C_KA + kvh * 64 + c4 * 8; kx1[t] = *(const u32x4*)src; kx2[t] = *(const u32x4*)(src + 32);
      const float* rt = RT + pos * 64 + c4 * 8; kc[t][0] = *(const f32x4*)rt; kc[t][1] = *(const f32x4*)(rt + 4); kc[t][2] = *(const f32x4*)(rt + 32); kc[t][3] = *(const f32x4*)(rt + 36); }
    const int dpp = task & 31, kg = task >> 5;
#pragma unroll
    for (int i = 0; i < 8; ++i) { const int vpos = q0 - 128 + kg * 8 + i; vv[t][i] = (task < 640 && vpos >= 0) ? *(const unsigned*)(Y1 + (rowb + vpos) * LDY + C_VA + kvh * 64 + 2 * dpp) : 0u; }
  }
  { const bf16* src = Y1 + (rowb + qpos) * LDY + C_QA + head * 64 + q * 8; qx1 = *(const u32x4*)src; qx2 = *(const u32x4*)(src + 32);
    const float* rt = RT + qpos * 64 + q * 8; qc[0] = *(const f32x4*)rt; qc[1] = *(const f32x4*)(rt + 4); qc[2] = *(const f32x4*)(rt + 32); qc[3] = *(const f32x4*)(rt + 36);
#pragma unroll
    for (int dt = 0; dt < 4; ++dt) zz[dt] = *(const u32x2*)(Y1 + (rowb + qpos) * LDY + C_ZA + head * 64 + dt * 16 + 4 * q); }
#pragma unroll
  for (int t = 0; t < 2; ++t) {
    const int task = tid + 512 * t;
    if (task < 640) {
      const int j = task >> 2, c4 = task & 3, pos = q0 - 128 + j;
      float o1[8], o2[8]; rope8r(kx1[t], kx2[t], kc[t], o1, o2);
      const u32x4 w1 = pack8(o1), w2 = pack8(o2);
      if (pos >= SEQ - 128 && j >= 128) { float* dst = p.out + O_PK + (((size_t)b * 128 + (pos - (SEQ - 128))) * 8 + kvh) * 64 + c4 * 8;
        *(f32x4*)dst = (f32x4){o1[0], o1[1], o1[2], o1[3]}; *(f32x4*)(dst + 4) = (f32x4){o1[4], o1[5], o1[6], o1[7]};
        *(f32x4*)(dst + 32) = (f32x4){o2[0], o2[1], o2[2], o2[3]}; *(f32x4*)(dst + 36) = (f32x4){o2[4], o2[5], o2[6], o2[7]}; }
      *(LAS u32x4*)(lds + AT_K + j * 144 + c4 * 16) = w1; *(LAS u32x4*)(lds + AT_K + j * 144 + 64 + c4 * 16) = w2;
      const int dpp = task & 31, kg = task >> 5;
#pragma unroll
      for (int i = 0; i < 8; ++i) { const int vpos = q0 - 128 + kg * 8 + i;
        if (vpos >= SEQ - 128 && kg >= 16) *(f32x2*)(p.out + O_PV + (((size_t)b * 128 + (vpos - (SEQ - 128))) * 8 + kvh) * 64 + 2 * dpp) = (f32x2){bflo(vv[t][i]), bfhi(vv[t][i])}; }
      u32x4 a, bq;
      a.x = (vv[t][0] & 0xffffu) | (vv[t][1] << 16); a.y = (vv[t][2] & 0xffffu) | (vv[t][3] << 16); a.z = (vv[t][4] & 0xffffu) | (vv[t][5] << 16); a.w = (vv[t][6] & 0xffffu) | (vv[t][7] << 16);
      bq.x = (vv[t][0] >> 16) | (vv[t][1] & 0xffff0000u); bq.y = (vv[t][2] >> 16) | (vv[t][3] & 0xffff0000u); bq.z = (vv[t][4] >> 16) | (vv[t][5] & 0xffff0000u); bq.w = (vv[t][6] >> 16) | (vv[t][7] & 0xffff0000u);
      *(LAS u32x4*)(lds + AT_VT + (2 * dpp) * 336 + kg * 16) = a; *(LAS u32x4*)(lds + AT_VT + (2 * dpp + 1) * 336 + kg * 16) = bq;
    }
  }
  bf16x8 qf0, qf1;
  { float o1[8], o2[8]; rope8r(qx1, qx2, qc, o1, o2); qf0 = __builtin_bit_cast(bf16x8, pack8(o1)); qf1 = __builtin_bit_cast(bf16x8, pack8(o2)); }
  __syncthreads();
  f32x4 o[4];
  const int klo0 = qt * 16 + r + 1, kmin = 128 - q0;
  attn_wave(lds, qf0, qf1, klo0 > kmin ? klo0 : kmin, qt * 16 + r + 128, p.in[I_SINK][head], o);
  attn_store_z(p, o, zz, rowb + qpos, head);
  __syncthreads();
}
DI void attn_sample_item(const Params& p, LAS unsigned char* lds, int item) {
  const int tid = TID(), lane = tid & 63, w = tid >> 6, r = lane & 15, q = lane >> 4;
  const int kvh = item & 7, b = item >> 3;
  const bf16* Y1 = (const bf16*)(p.ws + WS_Y1); const float* RT = (const float*)(p.ws + WS_ROPE);
  const size_t rowb = (size_t)NPR + (size_t)b * 8;
  const float* CK = p.in[I_CK] + (size_t)b * 128 * 512 + kvh * 64; const float* CV = p.in[I_CV] + (size_t)b * 128 * 512 + kvh * 64;
  float* OK = p.out + O_SK + (size_t)b * 128 * 512 + kvh * 64; float* OV = p.out + O_SV + (size_t)b * 128 * 512 + kvh * 64;
  const int jA = tid >> 2, c4 = tid & 3, jB = 128 + (tid >> 2), dpp = tid & 31, kgA = tid >> 5, kgB = 16 + (tid >> 5);
  const float* srcA = CK + (size_t)jA * 512 + c4 * 8;
  const f32x4 ka0 = __builtin_nontemporal_load((const f32x4*)srcA), ka1 = __builtin_nontemporal_load((const f32x4*)(srcA + 4)), kb0 = __builtin_nontemporal_load((const f32x4*)(srcA + 32)), kb1 = __builtin_nontemporal_load((const f32x4*)(srcA + 36));
  u32x4 nx1 = {0u, 0u, 0u, 0u}, nx2 = {0u, 0u, 0u, 0u}; f32x4 nc[4];
#pragma unroll
  for (int i = 0; i < 4; ++i) nc[i] = (f32x4){0.f, 0.f, 0.f, 0.f};
  if (tid < 32) { const int t = jB - 128; const bf16* src = Y1 + (rowb + t) * LDY + C_KA + kvh * 64 + c4 * 8; nx1 = *(const u32x4*)src; nx2 = *(const u32x4*)(src + 32);
    const float* rt = RT + (SEQ + t) * 64 + c4 * 8; nc[0] = *(const f32x4*)rt; nc[1] = *(const f32x4*)(rt + 4); nc[2] = *(const f32x4*)(rt + 32); nc[3] = *(const f32x4*)(rt + 36); }
  f32x2 va[8]; unsigned vb[8];
#pragma unroll
  for (int i = 0; i < 8; ++i) { va[i] = __builtin_nontemporal_load((const f32x2*)(CV + (size_t)(kgA * 8 + i) * 512 + 2 * dpp)); vb[i] = 0u; }
  if (tid < 32) {
#pragma unroll
    for (int i = 0; i < 8; ++i) vb[i] = *(const unsigned*)(Y1 + (rowb + i) * LDY + C_VA + kvh * 64 + 2 * dpp); }
  const int g = 2 * (w & 1) + (r >> 3), tq = r & 7, head = kvh * 4 + g;
  u32x4 qx1 = {0u, 0u, 0u, 0u}, qx2 = {0u, 0u, 0u, 0u}; f32x4 qc[4]; u32x2 zz[4];
#pragma unroll
  for (int i = 0; i < 4; ++i) { qc[i] = (f32x4){0.f, 0.f, 0.f, 0.f}; zz[i] = (u32x2){0u, 0u}; }
  if (w < 2) { const bf16* src = Y1 + (rowb + tq) * LDY + C_QA + head * 64 + q * 8; qx1 = *(const u32x4*)src; qx2 = *(const u32x4*)(src + 32);
    const float* rt = RT + (SEQ + tq) * 64 + q * 8; qc[0] = *(const f32x4*)rt; qc[1] = *(const f32x4*)(rt + 4); qc[2] = *(const f32x4*)(rt + 32); qc[3] = *(const f32x4*)(rt + 36);
#pragma unroll
    for (int dt = 0; dt < 4; ++dt) zz[dt] = *(const u32x2*)(Y1 + (rowb + tq) * LDY + C_ZA + head * 64 + dt * 16 + 4 * q); }
  asm volatile("" ::: "memory");
  { const float o1[8] = {ka0[0], ka0[1], ka0[2], ka0[3], ka1[0], ka1[1], ka1[2], ka1[3]}, o2[8] = {kb0[0], kb0[1], kb0[2], kb0[3], kb1[0], kb1[1], kb1[2], kb1[3]};
    *(LAS u32x4*)(lds + AT_K + jA * 144 + c4 * 16) = pack8(o1); *(LAS u32x4*)(lds + AT_K + jA * 144 + 64 + c4 * 16) = pack8(o2);
    if (jA >= 8) { float* dst = OK + (size_t)(jA - 8) * 512 + c4 * 8; __builtin_nontemporal_store(ka0, (f32x4*)dst); __builtin_nontemporal_store(ka1, (f32x4*)(dst + 4)); __builtin_nontemporal_store(kb0, (f32x4*)(dst + 32)); __builtin_nontemporal_store(kb1, (f32x4*)(dst + 36)); } }
  if (tid < 128) {
    u32x4 w1 = {0u, 0u, 0u, 0u}, w2 = {0u, 0u, 0u, 0u};
    if (tid < 32) { float o1[8], o2[8]; rope8r(nx1, nx2, nc, o1, o2); w1 = pack8(o1); w2 = pack8(o2);
      float* dst = OK + (size_t)(jB - 8) * 512 + c4 * 8;
      *(f32x4*)dst = (f32x4){o1[0], o1[1], o1[2], o1[3]}; *(f32x4*)(dst + 4) = (f32x4){o1[4], o1[5], o1[6], o1[7]};
      *(f32x4*)(dst + 32) = (f32x4){o2[0], o2[1], o2[2], o2[3]}; *(f32x4*)(dst + 36) = (f32x4){o2[4], o2[5], o2[6], o2[7]}; }
    *(LAS u32x4*)(lds + AT_K + jB * 144 + c4 * 16) = w1; *(LAS u32x4*)(lds + AT_K + jB * 144 + 64 + c4 * 16) = w2;
  }
  { float v0[8], v1[8];
#pragma unroll
    for (int i = 0; i < 8; ++i) { v0[i] = va[i].x; v1[i] = va[i].y; const int j = kgA * 8 + i; if (j >= 8) __builtin_nontemporal_store(va[i], (f32x2*)(OV + (size_t)(j - 8) * 512 + 2 * dpp)); }
    *(LAS u32x4*)(lds + AT_VT + (2 * dpp) * 336 + kgA * 16) = pack8(v0); *(LAS u32x4*)(lds + AT_VT + (2 * dpp + 1) * 336 + kgA * 16) = pack8(v1); }
  if (tid < 128) { float v0[8], v1[8];
#pragma unroll
    for (int i = 0; i < 8; ++i) { v0[i] = bflo(vb[i]); v1[i] = bfhi(vb[i]); if (tid < 32) *(f32x2*)(OV + (size_t)(120 + i) * 512 + 2 * dpp) = (f32x2){v0[i], v1[i]}; }
    *(LAS u32x4*)(lds + AT_VT + (2 * dpp) * 336 + kgB * 16) = pack8(v0); *(LAS u32x4*)(lds + AT_VT + (2 * dpp + 1) * 336 + kgB * 16) = pack8(v1); }
  __syncthreads();
  if (w < 2) {
    bf16x8 qf0, qf1;
    { float o1[8], o2[8]; rope8r(qx1, qx2, qc, o1, o2); qf0 = __builtin_bit_cast(bf16x8, pack8(o1)); qf1 = __builtin_bit_cast(bf16x8, pack8(o2)); }
    f32x4 o[4];
    attn_wave(lds, qf0, qf1, tq + 1, tq + 128, p.in[I_SINK][head], o);
    attn_store_z(p, o, zz, rowb + tq, head);
  }
  __syncthreads();
}
DI void phase_mixers(const Params& p, LAS unsigned char* lds) {
#ifndef ONLYIT
#define ONLYIT -1
#endif
#define ITON(k) (ONLYIT == -1 || ONLYIT == (k))
  if constexpr (ITON(0)) for (int it = BID(); it < 256; it += gridDim.x) mlstm_prompt_item(p, lds, it);
#ifdef DOUBLE_MP
  if constexpr (ITON(0)) for (int it = BID(); it < 256; it += gridDim.x) mlstm_prompt_item(p, lds, it);
#endif
#ifdef PROBE_SEL
  if (blockIdx.x == 0 && threadIdx.x == 0) ((LAS unsigned long long*)(lds + 163840 - 128))[9] = __builtin_amdgcn_s_memrealtime();
#endif
  constexpr int N_MS = 1024, N_AP = 4 * 64 * 8, N_AS = 1024;
  const int nround = (N_MS + N_AP + N_AS + (int)gridDim.x - 1) / (int)gridDim.x;
  for (int jj = 0; jj < nround; ++jj) {
    const int it = ((jj + BID()) % nround) * (int)gridDim.x + BID();
    if (it >= N_MS + N_AP + N_AS) continue;
    if (it < N_MS) { if constexpr (ITON(1)) { mlstm_sample_item(p, lds, it);
#ifdef DOUBLE_MS
      mlstm_sample_item(p, lds, it);
#endif
    } }
    else if (it < N_MS + N_AP) { if constexpr (ITON(2)) attn_prompt_item(p, lds, it - N_MS); }
    else { if constexpr (ITON(3)) attn_sample_item(p, lds, it - N_MS - N_AP); }
  }
}
DI void phase_headnorm(const Params& p) {
  const int lane = TID() & 63, gw = BID() * 8 + (TID() >> 6), NGW = gridDim.x * 8;
  const bf16* Y1 = (const bf16*)(p.ws + WS_Y1); const bf16* HB = (const bf16*)(p.ws + WS_HB); bf16* MIX = (bf16*)(p.ws + WS_MIX);
  for (int it0 = gw; it0 < NTOK * 8; it0 += 4 * NGW) {
    u32x2 hv4[4], zv4[4];
#pragma unroll
    for (int u = 0; u < 4; ++u) { const int it = it0 + u * NGW; const int row = it >> 3, h = it & 7;
      if (it < NTOK * 8) { hv4[u] = __builtin_nontemporal_load((const u32x2*)(HB + (size_t)row * 2048 + h * 256 + lane * 4)); zv4[u] = __builtin_nontemporal_load((const u32x2*)(Y1 + (size_t)row * LDY + C_ZM + h * 256 + lane * 4)); } }
    asm volatile("" ::: "memory");
#pragma unroll
    for (int u = 0; u < 4; ++u) { const int it = it0 + u * NGW; if (it >= NTOK * 8) break;
      const int row = it >> 3, h = it & 7;
      const u32x2 hv = hv4[u], zv = zv4[u];
      const f32x4 g = *(const f32x4*)(p.in[I_NMG] + h * 256 + lane * 4);
      float x[4] = {bflo(hv.x), bfhi(hv.x), bflo(hv.y), bfhi(hv.y)};
      const float z[4] = {bflo(zv.x), bfhi(zv.x), bflo(zv.y), bfhi(zv.y)};
      const float mu = wave_sum((x[0] + x[1]) + (x[2] + x[3])) * (1.f / 256.f);
      float s2 = 0.f;
#pragma unroll
      for (int j = 0; j < 4; ++j) { x[j] -= mu; s2 += x[j] * x[j]; }
      const float rstd = __builtin_amdgcn_rsqf(wave_sum(s2) * (1.f / 256.f) + 1e-5f);
      float o[4];
#pragma unroll
      for (int j = 0; j < 4; ++j) o[j] = x[j] * rstd * g[j] * z[j] * sigm(z[j]);
      u32x2 w; w.x = pk2(o[0], o[1]); w.y = pk2(o[2], o[3]);
      *(u32x2*)(MIX + (size_t)row * DM + h * 256 + lane * 4) = w;
    }
  }
}
DI void phase_reduce2(const Params& p) {
  const bf16* Y1 = (const bf16*)(p.ws + WS_Y1); bf16* MRG = (bf16*)(p.ws + WS_MRG); const float* P2 = (const float*)(p.ws + WS_P2);
  for (int idx = BID() * 512 + TID(); idx < 1024 * 512; idx += gridDim.x * 512) {
    const int r = idx >> 9, c8 = (idx & 511) * 8; const size_t row = NPR + r;
    const float* q = P2 + (size_t)r * DM + c8;
    const f32x4 m0 = *(const f32x4*)q + *(const f32x4*)(q + (size_t)1024 * DM), m1 = *(const f32x4*)(q + 4) + *(const f32x4*)(q + (size_t)1024 * DM + 4);
    const f32x4 a0 = *(const f32x4*)(q + (size_t)2048 * DM) + *(const f32x4*)(q + (size_t)3072 * DM), a1 = *(const f32x4*)(q + (size_t)2048 * DM + 4) + *(const f32x4*)(q + (size_t)3072 * DM + 4);
    const u32x4 gm = *(const u32x4*)(Y1 + row * LDY + C_GM + c8), ga = *(const u32x4*)(Y1 + row * LDY + C_GA + c8);
    u32x4 w;
    w.x = pk2(sigm(bflo(gm.x)) * m0[0] + sigm(bflo(ga.x)) * a0[0], sigm(bfhi(gm.x)) * m0[1] + sigm(bfhi(ga.x)) * a0[1]);
    w.y = pk2(sigm(bflo(gm.y)) * m0[2] + sigm(bflo(ga.y)) * a0[2], sigm(bfhi(gm.y)) * m0[3] + sigm(bfhi(ga.y)) * a0[3]);
    w.z = pk2(sigm(bflo(gm.z)) * m1[0] + sigm(bflo(ga.z)) * a1[0], sigm(bfhi(gm.z)) * m1[1] + sigm(bfhi(ga.z)) * a1[1]);
    w.w = pk2(sigm(bflo(gm.w)) * m1[2] + sigm(bflo(ga.w)) * a1[2], sigm(bfhi(gm.w)) * m1[3] + sigm(bfhi(ga.w)) * a1[3]);
    *(u32x4*)(MRG + row * DM + c8) = w;
  }
}
DI void phase_ln(const Params& p) {
  const int lane = TID() & 63, gw = BID() * 8 + (TID() >> 6), NGW = gridDim.x * 8;
  f32x4 G[16], Bv[16];
#pragma unroll
  for (int j = 0; j < 16; ++j) { G[j] = *(const f32x4*)(p.in[I_LNG] + j * 256 + lane * 4); Bv[j] = *(const f32x4*)(p.in[I_LNB] + j * 256 + lane * 4); }
  for (int row = gw; row < NTOK; row += NGW) {
    float* y = p.out + (size_t)row * DM;
    f32x4 v[16]; float s = 0.f;
#pragma unroll
    for (int j = 0; j < 16; ++j) {
      if (row < NPR) { const u32x2 zz = __builtin_nontemporal_load((const u32x2*)((const bf16*)(p.ws + WS_Z) + (size_t)row * DM + j * 256 + lane * 4)); v[j] = (f32x4){bflo(zz.x), bfhi(zz.x), bflo(zz.y), bfhi(zz.y)}; }
      else { const float* P3 = (const float*)(p.ws + WS_P3) + (size_t)(row - NPR) * DM + j * 256 + lane * 4;
        v[j] = *(const f32x4*)(p.in[I_XS] + (size_t)(row - NPR) * DM + j * 256 + lane * 4) * 1.18920711500272106672f
             + ((*(const f32x4*)P3 + *(const f32x4*)(P3 + (size_t)1024 * DM)) + (*(const f32x4*)(P3 + (size_t)2048 * DM) + *(const f32x4*)(P3 + (size_t)3072 * DM))); }
      s += (v[j][0] + v[j][1]) + (v[j][2] + v[j][3]); }
    const float mu = wave_sum(s) * (1.f / DM); float s2 = 0.f;
#pragma unroll
    for (int j = 0; j < 16; ++j) { v[j] = v[j] - mu; s2 += (v[j][0] * v[j][0] + v[j][1] * v[j][1]) + (v[j][2] * v[j][2] + v[j][3] * v[j][3]); }
    const float rstd = __builtin_amdgcn_rsqf(wave_sum(s2) * (1.f / DM) + 1e-5f);
#pragma unroll
    for (int j = 0; j < 16; ++j) *(f32x4*)(y + j * 256 + lane * 4) = v[j] * rstd * G[j] + Bv[j];
  }
}
struct EpiMerged {
  static constexpr bool PERM = true, AFTER_DRAIN = false, HAS_MID = true; static constexpr int MID_T = 32;
  const bf16* Y1; bf16* O; float* P;
  DI void mid(f32x4 (&acc)[2][2][4][2], const pg8::Unit& u, int wr, int wc, int fr, int fq) const {
    int row0 = u.pm * 256 + wr * 64 + fr, col0 = u.pn * 256 + wc * 32 + 8 * fq;
    asm volatile("" : "+v"(row0), "+v"(col0));
#pragma unroll
    for (int ai = 0; ai < 2; ++ai)
#pragma unroll
      for (int m = 0; m < 4; ++m) { const size_t row = row0 + ai * 128 + m * 16;
#pragma unroll
        for (int bj = 0; bj < 2; ++bj) { const int col = col0 + bj * 128;
          const u32x4 gm = *(const u32x4*)(Y1 + row * LDY + C_GM + col), ga = *(const u32x4*)(Y1 + row * LDY + C_GA + col);
          const unsigned gmw[4] = {gm.x, gm.y, gm.z, gm.w}, gaw[4] = {ga.x, ga.y, ga.z, ga.w};
#pragma unroll
          for (int j = 0; j < 4; ++j) { const float r0 = (1.f + __expf(-bflo(gaw[j]))) * rcpf_(1.f + __expf(-bflo(gmw[j]))), r1 = (1.f + __expf(-bfhi(gaw[j]))) * rcpf_(1.f + __expf(-bfhi(gmw[j])));
            acc[ai][bj][m][j >> 1][(j & 1) * 2] *= r0; acc[ai][bj][m][j >> 1][(j & 1) * 2 + 1] *= r1; } }
        if (m & 1) asm volatile("" ::: "memory"); }
  }
  DI void operator()(const f32x4 (&acc)[2][2][4][2], const pg8::Unit& u, int wr, int wc, int fr, int fq) const {
    const int row0 = u.pm * 256 + wr * 64 + fr, col0 = u.pn * 256 + wc * 32 + 8 * fq;
    if (u.kind == 0) {
#pragma unroll
      for (int ai = 0; ai < 2; ++ai) {
        u32x4 gg[4][2];
#pragma unroll
        for (int m = 0; m < 4; ++m)
#pragma unroll
          for (int bj = 0; bj < 2; ++bj) gg[m][bj] = *(const u32x4*)(Y1 + (size_t)(row0 + ai * 128 + m * 16) * LDY + C_GA + col0 + bj * 128);
        asm volatile("" ::: "memory");
#pragma unroll
        for (int m = 0; m < 4; ++m) { const size_t row = row0 + ai * 128 + m * 16;
#pragma unroll
          for (int bj = 0; bj < 2; ++bj) { const int col = col0 + bj * 128;
            const u32x4 g = gg[m][bj];
            const f32x4 v0 = acc[ai][bj][m][0], v1 = acc[ai][bj][m][1];
            u32x4 w; w.x = pk2(sigm(bflo(g.x)) * v0[0], sigm(bfhi(g.x)) * v0[1]); w.y = pk2(sigm(bflo(g.y)) * v0[2], sigm(bfhi(g.y)) * v0[3]);
            w.z = pk2(sigm(bflo(g.z)) * v1[0], sigm(bfhi(g.z)) * v1[1]); w.w = pk2(sigm(bflo(g.w)) * v1[2], sigm(bfhi(g.w)) * v1[3]);
            *(u32x4*)(O + row * DM + col) = w; } } }
    } else {
      float* Pq = P + (size_t)(u.k0 / u.nk) * 1024 * DM;
#pragma unroll
      for (int ai = 0; ai < 2; ++ai)
#pragma unroll
        for (int m = 0; m < 4; ++m) { const size_t row = row0 + ai * 128 + m * 16 - NPR;
#pragma unroll
          for (int bj = 0; bj < 2; ++bj) { const int col = col0 + bj * 128;
            *(f32x4*)(Pq + row * DM + col) = acc[ai][bj][m][0]; *(f32x4*)(Pq + row * DM + col + 4) = acc[ai][bj][m][1]; } }
    }
  }
};
struct EpiOut {
  static constexpr bool PERM = false, AFTER_DRAIN = false, HAS_MID = false; static constexpr int MID_T = 0;
  const float* xp; const float* xs; bf16* Z; float* P;
  DI void operator()(const f32x4 (&acc)[2][2][4][2], const pg8::Unit& u, int wr, int wc, int fr, int fq) const {
    const int row0 = u.pm * 256 + wr * 64 + fr, col0 = u.pn * 256 + wc * 32 + 4 * fq;
    const float alpha = 1.18920711500272106672f;
    if (u.kind != 0) {
      float* Pq = P + (size_t)(u.k0 / u.nk) * 1024 * DM;
#pragma unroll
      for (int ai = 0; ai < 2; ++ai)
#pragma unroll
        for (int m = 0; m < 4; ++m) { const size_t row = row0 + ai * 128 + m * 16 - NPR;
#pragma unroll
          for (int bj = 0; bj < 2; ++bj)
#pragma unroll
            for (int n = 0; n < 2; ++n) *(f32x4*)(Pq + row * DM + col0 + bj * 128 + n * 16) = acc[ai][bj][m][n]; }
      return;
    }
#pragma unroll
    for (int ai = 0; ai < 2; ++ai) {
      f32x4 xv[4][2][2];
#pragma unroll
      for (int m = 0; m < 4; ++m) { const size_t row = row0 + ai * 128 + m * 16;
        const float* xr = row < NPR ? xp + row * DM : xs + (row - NPR) * DM;
#pragma unroll
        for (int bj = 0; bj < 2; ++bj)
#pragma unroll
          for (int n = 0; n < 2; ++n) xv[m][bj][n] = __builtin_nontemporal_load((const f32x4*)(xr + col0 + bj * 128 + n * 16)); }
      asm volatile("" ::: "memory");
#pragma unroll
      for (int m = 0; m < 4; ++m) { const size_t row = row0 + ai * 128 + m * 16;
#pragma unroll
        for (int bj = 0; bj < 2; ++bj)
#pragma unroll
          for (int n = 0; n < 2; ++n) { const int col = col0 + bj * 128 + n * 16;
            const f32x4 zv = xv[m][bj][n] * alpha + acc[ai][bj][m][n];
            u32x2 w; w.x = pk2(zv[0], zv[1]); w.y = pk2(zv[2], zv[3]);
            *(u32x2*)(Z + row * DM + col) = w; } }
    }
  }
};
#define XB_TMO      128
#define XB_XCNT(j)  (256  + 64 * (j))
#define XB_XSUB(j)  (1280 + 64 * (j))
#define XB_XGEN(j)  (2304 + 64 * (j))
#define XB_TOP      3328
#define XB_TOPGEN   3392
#define XCD_BAR_WORDS 3456
#define XB_SPIN_CAP (1u << 18)

__device__ __forceinline__ unsigned xb_ld(unsigned* p)              { return __hip_atomic_load(p, __ATOMIC_RELAXED, __HIP_MEMORY_SCOPE_AGENT); }
__device__ __forceinline__ unsigned xb_add(unsigned* p, unsigned v) { return __hip_atomic_fetch_add(p, v, __ATOMIC_RELAXED, __HIP_MEMORY_SCOPE_AGENT); }
__device__ __forceinline__ unsigned xb_xcc_id() { return (unsigned)__builtin_amdgcn_s_getreg((3 << 11) | 20) & 0xFu; }
#define XB_SPIN(cond, bar) do { unsigned _sp = 0; while (cond) { __builtin_amdgcn_s_sleep(1); \
    if ((++_sp & 255u) == 0u) { if (xb_ld(&(bar)[XB_TMO])) break; if (_sp > XB_SPIN_CAP) { atomicAdd(&(bar)[XB_TMO], 1u); break; } } } } while (0)

struct XcdBarrier {
    unsigned* bar; unsigned x;
    volatile LAS unsigned* st;
};

__device__ __forceinline__ XcdBarrier xcd_barrier_post(unsigned* bar, volatile LAS unsigned* st) {
    XcdBarrier b; b.bar = bar; b.x = xb_xcc_id(); b.st = st;
    if (threadIdx.x == 0) (void)xb_add(&bar[XB_XCNT(b.x)], 1u);
    return b;
}
__device__ __forceinline__ void xcd_barrier_complete(unsigned* bar, unsigned x, unsigned& nloc, unsigned& nx) {
    const unsigned G = gridDim.x * gridDim.y * gridDim.z;
    unsigned sum, cnt, mine, sp = 0u;
    for (;;) {
        sum = 0u; cnt = 0u; mine = 0u;
#pragma unroll
        for (unsigned j = 0; j < 16; ++j) { const unsigned c = xb_ld(&bar[XB_XCNT(j)]); sum += c; cnt += (c > 0u) ? 1u : 0u; mine = (j == x) ? c : mine; }
        if (sum == G) break;
        __builtin_amdgcn_s_sleep(1);
        if ((++sp & 255u) == 0u) { if (xb_ld(&bar[XB_TMO])) break; if (sp > XB_SPIN_CAP) { atomicAdd(&bar[XB_TMO], 1u); break; } }
    }
    nloc = mine > 0u ? mine : 1u; nx = cnt > 0u ? cnt : 1u;
}

__device__ __forceinline__ void xcd_barrier(const XcdBarrier& b) {
    asm volatile("s_waitcnt vmcnt(0)" ::: "memory");
    __syncthreads();
    if (threadIdx.x == 0) {
        unsigned* bar = b.bar;
        __builtin_amdgcn_s_waitcnt(0);
        unsigned nloc = b.st[0], nx = b.st[1];
        if (nloc == 0u) { xcd_barrier_complete(bar, b.x, nloc, nx); b.st[0] = nloc; b.st[1] = nx; }
        const unsigned old = xb_add(&bar[XB_XSUB(b.x)], 1u);
        const unsigned gen = old / nloc;
        if (old + 1u == (gen + 1u) * nloc) {
            __builtin_amdgcn_fence(__ATOMIC_RELEASE, "agent");
            asm volatile("s_waitcnt vmcnt(0)" ::: "memory");
            const unsigned og = xb_add(&bar[XB_TOP], 1u);
            const unsigned tg = og / nx;
            if (og + 1u == (tg + 1u) * nx) xb_add(&bar[XB_TOPGEN], 1u);
            else XB_SPIN(xb_ld(&bar[XB_TOPGEN]) == tg, bar);
            __builtin_amdgcn_fence(__ATOMIC_ACQUIRE, "agent");
            xb_add(&bar[XB_XGEN(b.x)], 1u);
            asm volatile("s_waitcnt vmcnt(0)" ::: "memory");
        } else {
            XB_SPIN(xb_ld(&bar[XB_XGEN(b.x)]) == gen, bar);
            __builtin_amdgcn_fence(__ATOMIC_ACQUIRE, "agent");
            asm volatile("s_waitcnt vmcnt(0)" ::: "memory");
        }
    }
    __syncthreads();
}

constexpr int NPHASES = 8;
__global__ void __launch_bounds__(512) mega(Params p) {
  extern __shared__ __attribute__((aligned(16))) unsigned char lds_raw[];
  LAS unsigned char* lds = (LAS unsigned char*)lds_raw;
  cg::grid_group grid = cg::this_grid();
  volatile LAS unsigned* xst = (volatile LAS unsigned*)(lds + 163840 - 16);
  unsigned* xbar = (unsigned*)(p.ws + WS_BAR);
  if (threadIdx.x == 0) { xst[0] = 0u; xst[1] = 0u; }
  __syncthreads();
  (void)xcd_barrier_post(xbar, xst);
#ifdef PROBE_SEL
  LAS unsigned long long* TS = (LAS unsigned long long*)(lds + 163840 - 128);
  const bool tsw = (blockIdx.x == 0 && threadIdx.x == 0);
  if (tsw) TS[0] = __builtin_amdgcn_s_memrealtime();
#endif
  for (int ph = p.ph_lo; ph < p.ph_hi; ++ph) {
#ifndef ONLYPH
#define ONLYPH -1
#endif
#define PHON(k) (ONLYPH == -1 || ONLYPH == (k))
    if (ph == 0) { if constexpr (PHON(0)) { phase0(p, lds);
#ifdef DOUBLE_PH0
      __syncthreads(); phase0(p, lds);
#endif
    } }
    else if (ph == 1) { if constexpr (PHON(1)) {
#ifdef PROBE_SEL
      if (tsw) TS[10] = __builtin_amdgcn_s_memtime();
#endif
      pg8::Gemm g{(const bf16*)(p.ws + WS_XB), (const bf16*)(p.ws + WS_WINT), NTOK, LDY, DM, DM, DM};
      pg8::BandOrder S; S.init(gridDim.x, BID(), 64);
      pg8::EpiBf16<0> E{(bf16*)(p.ws + WS_Y1), LDY, nullptr, 0, 0};
      pg8::gemm_phase<pg8::EpiBf16<0>, pg8::BandOrder, true, true>(lds, g, S, E);
#ifdef DOUBLE_PH1
      __syncthreads(); pg8::gemm_phase<pg8::EpiBf16<0>, pg8::BandOrder, true, true>(lds, g, S, E);
#endif
#ifdef PROBE_SEL
      if (tsw) TS[11] = __builtin_amdgcn_s_memtime();
#endif
    } } else if (ph == 2) { if constexpr (PHON(2)) { phase_mixers(p, lds);
#ifdef DOUBLE_PH2
      __syncthreads(); phase_mixers(p, lds);
#endif
    } }
    else if (ph == 3) { if constexpr (PHON(3)) phase_headnorm(p); }
    else if (ph == 4) { if constexpr (PHON(4)) {
      pg8::Gemm g{(const bf16*)(p.ws + WS_MIX), (const bf16*)(p.ws + WS_WBT), NTOK, DM, DM, DM, DM};
      pg8::TailSplitOrder S; S.init(gridDim.x, BID(), 64);
      EpiMerged E{(const bf16*)(p.ws + WS_Y1), (bf16*)(p.ws + WS_MRG), (float*)(p.ws + WS_P2)};
      pg8::gemm_phase<EpiMerged, pg8::TailSplitOrder, true, true>(lds, g, S, E);
    } } else if (ph == 5) { if constexpr (PHON(5)) phase_reduce2(p); }
    else if (ph == 6) { if constexpr (PHON(6)) {
      pg8::Gemm g{(const bf16*)(p.ws + WS_MRG), (const bf16*)(p.ws + WS_WOT), NTOK, DM, DM, DM, DM};
      pg8::TailSplitOrder S; S.init(gridDim.x, BID(), 64);
      EpiOut E{p.in[I_XP], p.in[I_XS], (bf16*)(p.ws + WS_Z), (float*)(p.ws + WS_P3)};
      pg8::gemm_phase<EpiOut, pg8::TailSplitOrder, true, true>(lds, g, S, E);
    } } else { if constexpr (PHON(7)) phase_ln(p); }
#ifdef PROBE_SEL
    grid.sync();
    if (tsw) TS[ph + 1] = __builtin_amdgcn_s_memrealtime();
#else
    if (ph + 1 < p.ph_hi) {
      if (p.ph_lo < 0) grid.sync();
      XcdBarrier xb; xb.bar = xbar; xb.x = xb_xcc_id(); xb.st = xst;
      xcd_barrier(xb);
    }
#endif
  }
#ifdef PROBE_SEL
  if (blockIdx.x == 0) { __syncthreads();
    const float tot = (float)(TS[8] - TS[0]);
    float a, b;
    if (PROBE_SEL == 1) { a = (float)(TS[1] - TS[0]); b = (float)(TS[2] - TS[1]); }
    else if (PROBE_SEL == 2) { a = (float)(TS[9] - TS[2]); b = (float)(TS[3] - TS[9]); }
    else if (PROBE_SEL == 3) { a = (float)(TS[6] - TS[4]); b = (float)(TS[7] - TS[6]); }
    else { a = (float)(TS[4] - TS[3]); b = (float)(TS[8] - TS[7]); }
    int qa = (int)(a / tot * 300.f), qb = (int)(b / tot * 300.f);
    if (PROBE_SEL == 6) { qa = (int)((float)(TS[2] - TS[1]) / 1000.f); qb = (int)((float)(TS[3] - TS[2]) / 1000.f); qa = qa > 299 ? 299 : qa; qb = qb > 299 ? 299 : qb; }
    if (PROBE_SEL == 5) { const float cyc = (float)(TS[11] - TS[10]), rt = (float)(TS[2] - TS[1]); qa = (int)(cyc / 832.f / 20.f); qb = (int)(cyc / rt * 10.f); } qa = qa > 299 ? 299 : qa; qb = qb > 299 ? 299 : qb;
    const float f = (float)(qa * 300 + qb) / 90000.f, eps = 0.01f * (1.f + f);
    for (int i = threadIdx.x; i < 1024; i += 512) p.out[O_SM + i] *= (1.f + eps);
  }
#endif
}
#ifndef N_LAUNCH_PER_PHASE
#define N_LAUNCH_PER_PHASE 0
#endif
extern "C" void kernel_launch(void* const* d_in, const int* in_sizes, int n_in, void* d_out, int out_size, void* d_ws, size_t ws_size, hipStream_t stream) {
  constexpr int LDSB = 160 * 1024;
  static int grid = 0;
  if (!grid) {
    int dev = 0, cus = 0;
    if (n_in != 16 || ws_size < WS_END || out_size != 124527648) { fprintf(stderr, "kernel_launch: unexpected sizes n_in %d ws %zu (need %zu) out %d\n", n_in, ws_size, (size_t)WS_END, out_size); grid = -1; return; }
    (void)hipGetDevice(&dev);
    (void)hipDeviceGetAttribute(&cus, hipDeviceAttributeMultiprocessorCount, dev);
    (void)hipFuncSetAttribute((const void*)mega, hipFuncAttributeMaxDynamicSharedMemorySize, LDSB);
    grid = cus;
  }
  if (grid < 0) return;
  (void)hipMemsetAsync((char*)d_ws + WS_BAR, 0, XCD_BAR_WORDS * 4, stream);
  Params p{};
  for (int i = 0; i < 16; ++i) p.in[i] = (const float*)d_in[i];
  p.out = (float*)d_out; p.ws = (unsigned char*)d_ws;
#if N_LAUNCH_PER_PHASE
  for (int ph = 0; ph < NPHASES; ++ph) { p.ph_lo = ph; p.ph_hi = ph + 1; hipLaunchKernelGGL(mega, dim3(grid), dim3(512), LDSB, stream, p); }
#else
  p.ph_lo = 0; p.ph_hi = NPHASES;
  void* args[] = {&p};
  hipError_t e = hipLaunchCooperativeKernel((const void*)mega, dim3(grid), dim3(512), args, LDSB, stream);
  if (e != hipSuccess) fprintf(stderr, "cooperative launch failed: %s (grid %d)\n", hipGetErrorString(e), grid);
#endif
}
```
